# Optimizing an MI355X kernel written in HIP

```python
import jax, jax.numpy as jnp
from jax import lax
import numpy as np

D_MODEL = 1024
BATCH = 8
SEQ = 4096
DEPTH = 1

HEAD_DIM = 64
ATTN_HEADS = 8
ATTN_WIDTH = ATTN_HEADS * HEAD_DIM
RWKV_HEADS = 8
RWKV_WIDTH = RWKV_HEADS * HEAD_DIM
MIX_WIDTH = ATTN_WIDTH + RWKV_WIDTH
DECAY_RANK = 64
ICLR_RANK = 64
MOBA_BLOCK = 256
MOBA_TOPK = 3
Q_CHUNK = 32
ROPE_THETA = 10000.0
RMS_EPS = 1e-6
GN_EPS = 64e-5
NORMALIZE_EPS_SQ = 1e-24

SHIFT_WIDTH = 3 * RWKV_WIDTH + DECAY_RANK + ICLR_RANK
IN_WIDTH = 4 * ATTN_WIDTH + SHIFT_WIDTH + RWKV_WIDTH
B_SHIFT_START = 4 * ATTN_WIDTH
B_GATE_START = B_SHIFT_START + SHIFT_WIDTH

kernel_name = 'hybrid_moba_rwkv7_parallel_heads'


def rms_norm(x, gain):
    xf = x.astype(jnp.float32)
    return xf * lax.rsqrt(jnp.mean(xf * xf, axis=-1, keepdims=True) + RMS_EPS) * gain.astype(jnp.float32)


def rotary(x):
    t, d = x.shape[2], x.shape[3]
    inv_freq = 1.0 / (ROPE_THETA ** (jnp.arange(0, d, 2, dtype=jnp.float32) / d))
    ang = jnp.arange(t, dtype=jnp.float32)[:, None] * inv_freq[None, :]
    cos, sin = jnp.cos(ang), jnp.sin(ang)
    x1, x2 = x[..., : d // 2], x[..., d // 2:]
    return jnp.concatenate([x1 * cos - x2 * sin, x2 * cos + x1 * sin], axis=-1)


def moba_attention(q, k, v):
    b, h, t, d = q.shape
    nb = -(-t // MOBA_BLOCK)
    t_pad = nb * MOBA_BLOCK
    pad = ((0, 0), (0, 0), (0, t_pad - t), (0, 0))
    q, k, v = jnp.pad(q, pad), jnp.pad(k, pad), jnp.pad(v, pad)
    kb = k.reshape(b, h, nb, MOBA_BLOCK, d)
    vb = v.reshape(b, h, nb, MOBA_BLOCK, d)
    k_mean = kb.mean(axis=3)
    n_sel = min(MOBA_TOPK, nb)
    scale = d ** -0.5
    b_idx = jnp.arange(b)[:, None, None, None]
    h_idx = jnp.arange(h)[None, :, None, None]
    block_ids = jnp.arange(nb)

    def query_chunk(i):
        start = i * Q_CHUNK
        cur = start // MOBA_BLOCK
        qc = lax.dynamic_slice_in_dim(q, start, Q_CHUNK, axis=2)
        gate = jnp.einsum('bhqd,bhnd->bhqn', qc, k_mean)
        gate = jnp.where(block_ids < cur, gate, -jnp.inf)
        _, sel = lax.top_k(gate, n_sel)
        sel_ok = jnp.arange(n_sel) < cur
        k_sel = kb[b_idx, h_idx, sel]
        v_sel = vb[b_idx, h_idx, sel]
        s_sel = jnp.einsum('bhqd,bhqjsd->bhqjs', qc, k_sel) * scale
        s_sel = jnp.where(sel_ok[:, None], s_sel, -jnp.inf)
        k_own = lax.dynamic_index_in_dim(kb, cur, axis=2, keepdims=False)
        v_own = lax.dynamic_index_in_dim(vb, cur, axis=2, keepdims=False)
        s_own = jnp.einsum('bhqd,bhsd->bhqs', qc, k_own) * scale
        q_pos = start + jnp.arange(Q_CHUNK)
        k_pos = cur * MOBA_BLOCK + jnp.arange(MOBA_BLOCK)
        s_own = jnp.where(k_pos[None, :] <= q_pos[:, None], s_own, -jnp.inf)
        scores = jnp.concatenate([s_sel.reshape(b, h, Q_CHUNK, n_sel * MOBA_BLOCK), s_own], axis=-1)
        probs = jax.nn.softmax(scores, axis=-1)
        p_sel = probs[..., : n_sel * MOBA_BLOCK].reshape(b, h, Q_CHUNK, n_sel, MOBA_BLOCK)
        p_own = probs[..., n_sel * MOBA_BLOCK:]
        return (jnp.einsum('bhqjs,bhqjsd->bhqd', p_sel, v_sel)
                + jnp.einsum('bhqs,bhsd->bhqd', p_own, v_own))

    out = lax.map(query_chunk, jnp.arange(t_pad // Q_CHUNK))
    out = jnp.moveaxis(out, 0, 2).reshape(b, h, t_pad, d)
    return out[:, :, :t]


def rwkv7_time_mix(p, shift_mu, decay_bias, decay_up, iclr_bias, iclr_up, k_k, k_a, r_k, gn_gain, gn_bias):
    f32 = jnp.float32
    p = p.astype(f32)
    b, t, _ = p.shape
    c = RWKV_WIDTH
    prev = jnp.pad(p[:, :-1], ((0, 0), (1, 0), (0, 0)))
    p = p + (prev - p) * shift_mu.astype(f32)
    r, k, v = p[..., :c], p[..., c:2 * c], p[..., 2 * c:3 * c]
    w_down = p[..., 3 * c:3 * c + DECAY_RANK]
    a_down = p[..., 3 * c + DECAY_RANK:]
    w_log = -jax.nn.softplus(-(decay_bias.astype(f32) + jnp.tanh(w_down) @ decay_up.astype(f32))) - 0.5
    decay = jnp.exp(-jnp.exp(w_log))
    a = jax.nn.sigmoid(iclr_bias.astype(f32) + a_down @ iclr_up.astype(f32))
    kk = k * k_k.astype(f32)
    k = k * (1.0 + (a - 1.0) * k_a.astype(f32))
    heads = lambda z: z.reshape(b, t, RWKV_HEADS, HEAD_DIM)
    r, k, v, decay, a, kk = (heads(z) for z in (r, k, v, decay, a, kk))
    kk = kk * lax.rsqrt(jnp.maximum(jnp.sum(kk * kk, axis=-1, keepdims=True), NORMALIZE_EPS_SQ))

    def step(state, inp):
        r_t, w_t, k_t, v_t, kk_t, a_t = inp
        sa = jnp.einsum('bhvk,bhk->bhv', state, -kk_t)
        state = (state * w_t[:, :, None, :]
                 + sa[..., None] * (kk_t * a_t)[:, :, None, :]
                 + v_t[..., None] * k_t[:, :, None, :])
        return state, jnp.einsum('bhvk,bhk->bhv', state, r_t)

    seq_first = lambda z: jnp.moveaxis(z, 1, 0)
    state0 = jnp.zeros((b, RWKV_HEADS, HEAD_DIM, HEAD_DIM), f32)
    _, y = lax.scan(step, state0, tuple(seq_first(z) for z in (r, decay, k, v, kk, a)))
    y = jnp.moveaxis(y, 0, 1)
    mu = jnp.mean(y, axis=-1, keepdims=True)
    var = jnp.mean(jnp.square(y - mu), axis=-1, keepdims=True)
    y = ((y - mu) * lax.rsqrt(var + GN_EPS)).reshape(b, t, c) * gn_gain.astype(f32) + gn_bias.astype(f32)
    bonus = jnp.sum(r * k * r_k.astype(f32), axis=-1, keepdims=True) * v
    return y + bonus.reshape(b, t, c)


def setup_inputs(seed: int = 0) -> dict:
    key = jax.random.key(seed)
    ks = jax.random.split(key, 16)
    f32 = jnp.float32
    nrm = lambda kk, shape, s: s * jax.random.normal(kk, shape, f32)
    L = DEPTH
    return {
        'x': jax.random.normal(ks[0], (BATCH, SEQ, D_MODEL), f32),
        'norm_gain': 1.0 + nrm(ks[1], (L, D_MODEL), 0.02),
        'w_in': nrm(ks[2], (L, D_MODEL, IN_WIDTH), D_MODEL ** -0.5),
        'shift_mu': jax.random.uniform(ks[3], (L, SHIFT_WIDTH), f32),
        'decay_bias': nrm(ks[4], (L, RWKV_WIDTH), 0.5) - 2.0,
        'decay_up': nrm(ks[5], (L, DECAY_RANK, RWKV_WIDTH), 0.5 * DECAY_RANK ** -0.5),
        'iclr_bias': nrm(ks[6], (L, RWKV_WIDTH), 0.5),
        'iclr_up': nrm(ks[7], (L, ICLR_RANK, RWKV_WIDTH), ICLR_RANK ** -0.5),
        'k_k': 0.85 + nrm(ks[8], (L, RWKV_WIDTH), 0.1),
        'k_a': 1.0 + nrm(ks[9], (L, RWKV_WIDTH), 0.1),
        'r_k': nrm(ks[10], (L, RWKV_HEADS, HEAD_DIM), 0.1),
        'gn_gain': 1.0 + nrm(ks[11], (L, RWKV_WIDTH), 0.02),
        'gn_bias': nrm(ks[12], (L, RWKV_WIDTH), 0.02),
        'w_out': nrm(ks[13], (L, MIX_WIDTH, D_MODEL), MIX_WIDTH ** -0.5),
        'final_gain': 1.0 + nrm(ks[14], (D_MODEL,), 0.02),
    }


def reference(x, norm_gain, w_in, shift_mu, decay_bias, decay_up, iclr_bias, iclr_up,
              k_k, k_a, r_k, gn_gain, gn_bias, w_out, final_gain):
    f32 = jnp.float32
    b, t, _ = x.shape
    h = x.astype(f32)
    to_heads = lambda z: z.reshape(b, t, ATTN_HEADS, HEAD_DIM).transpose(0, 2, 1, 3)
    for layer in range(DEPTH):
        u = rms_norm(h, norm_gain[layer])
        p = jnp.einsum('btd,dc->btc', u, w_in[layer].astype(f32))
        q = rotary(to_heads(p[..., 0:ATTN_WIDTH]))
        k = rotary(to_heads(p[..., ATTN_WIDTH:2 * ATTN_WIDTH]))
        v = to_heads(p[..., 2 * ATTN_WIDTH:3 * ATTN_WIDTH])
        y_a = moba_attention(q, k, v).transpose(0, 2, 1, 3).reshape(b, t, ATTN_WIDTH)
        y_a = y_a * jax.nn.silu(p[..., 3 * ATTN_WIDTH:4 * ATTN_WIDTH])
        y_b = rwkv7_time_mix(p[..., B_SHIFT_START:B_GATE_START], shift_mu[layer], decay_bias[layer],
                             decay_up[layer], iclr_bias[layer], iclr_up[layer], k_k[layer], k_a[layer],
                             r_k[layer], gn_gain[layer], gn_bias[layer])
        y_b = y_b * jax.nn.silu(p[..., B_GATE_START:])
        h = h + jnp.einsum('btc,cd->btd', jnp.concatenate([y_a, y_b], axis=-1), w_out[layer].astype(f32))
    return rms_norm(h, final_gain).astype(x.dtype)
```

```cpp
#include <hip/hip_runtime.h>
#include <hip/hip_cooperative_groups.h>
#include <cstdio>
#include <cstdint>
#include <type_traits>
namespace cg = cooperative_groups;

#ifndef DBG_STAGE
#define DBG_STAGE 3
#endif
#ifndef ATTN_SGB
#define ATTN_SGB 0
#endif
#ifndef REP
#define REP 0
#endif
#ifndef N_LAUNCH_SPLIT
#define N_LAUNCH_SPLIT 0
#endif

typedef unsigned short u16;
typedef short bf16x8 __attribute__((ext_vector_type(8)));
typedef float f32x4 __attribute__((ext_vector_type(4)));
typedef float f32x16 __attribute__((ext_vector_type(16)));
typedef unsigned u32x2 __attribute__((ext_vector_type(2)));
typedef unsigned u32x4 __attribute__((ext_vector_type(4)));

constexpr int NT = 512;
constexpr int DM = 1024, BATCH = 8, SEQ = 4096, TOK = BATCH * SEQ;
constexpr int INW = 4224, PBW = 1664;
constexpr int LDS_BYTES = 148 * 1024;
constexpr int LD = 72;

struct Params {
  const float *x, *norm_gain, *w_in, *shift_mu, *decay_bias, *decay_up, *iclr_bias, *iclr_up, *k_k, *k_a, *r_k, *gn_gain, *gn_bias, *w_out, *final_gain;
  float* out;
  u16 *xb, *winT, *woutT, *Q, *K, *Vt, *GA, *PB, *GB, *Ymix, *DUt, *IUt, *Pm, *Ry, *BV, *Hs;
  float *rs, *ctab, *stab, *kmean, *ssq;
  u16 *QT, *Y0;
  int* qctr;
  int* pcnt;
  unsigned* xbar;
};

typedef __bf16 bf16x2_t __attribute__((ext_vector_type(2)));
typedef float f32x2_t __attribute__((ext_vector_type(2)));
__device__ __forceinline__ unsigned pk2(float lo, float hi) { f32x2_t v = {lo, hi}; bf16x2_t b = __builtin_convertvector(v, bf16x2_t); return __builtin_bit_cast(unsigned, b); }
__device__ __forceinline__ float bf2f(unsigned v) { return __uint_as_float(v << 16); }
__device__ __forceinline__ float bflo(unsigned v) { return __uint_as_float(v << 16); }
__device__ __forceinline__ float bfhi(unsigned v) { return __uint_as_float(v & 0xffff0000u); }
__device__ __forceinline__ int rm32(int reg, int h) { return (reg & 3) + 8 * (reg >> 2) + 4 * h; }
__device__ __forceinline__ float fexp(float x) { return __builtin_amdgcn_exp2f(x * 1.44269504088896f); }
__device__ __forceinline__ float fsigmoid(float x) { return __builtin_amdgcn_rcpf(1.f + fexp(-x)); }

__device__ void transpose_bf16(const float* __restrict__ src, int Kr, int Nc, u16* __restrict__ dst, const float* __restrict__ rowscale, char* lds, int bid, int nb) {
  float* ts = (float*)lds;
  const int tid = threadIdx.x;
  const int tk = Kr / 64, tn = Nc / 64;
  for (int t = bid; t < tk * tn; t += nb) {
    const int k0 = (t / tn) * 64, c0 = (t % tn) * 64;
#pragma unroll
    for (int i = 0; i < 2; ++i) {
      const int r = (tid >> 4) + 32 * i, c4 = (tid & 15) * 4;
      f32x4 v = *(const f32x4*)(src + (size_t)(k0 + r) * Nc + c0 + c4);
      const float sc = rowscale ? rowscale[k0 + r] : 1.f;
#pragma unroll
      for (int e = 0; e < 4; ++e) ts[(c4 + e) * 65 + r] = v[e] * sc;
    }
    __syncthreads();
    {
      const int c = tid >> 3, ch = tid & 7;
      const float* tp = ts + c * 65 + ch * 8;
      u32x4 w; w.x = pk2(tp[0], tp[1]); w.y = pk2(tp[2], tp[3]); w.z = pk2(tp[4], tp[5]); w.w = pk2(tp[6], tp[7]);
      *(u32x4*)(dst + (size_t)(c0 + c) * Kr + k0 + ch * 8) = w;
    }
    __syncthreads();
  }
}

__device__ void phase_prep(const Params& p, char* lds, int bid, int nb) {
  const int tid = threadIdx.x, lane = tid & 63, wave = tid >> 6;
  for (int row = bid * 8 + wave; row < TOK; row += nb * 8) {
    const float* xr = p.x + (size_t)row * DM;
    float ss = 0.f;
#pragma unroll
    for (int i = 0; i < 4; ++i) {
      f32x4 v = *(const f32x4*)(xr + i * 256 + lane * 4);
      ss += v[0] * v[0] + v[1] * v[1] + v[2] * v[2] + v[3] * v[3];
      u32x2 w; w.x = pk2(v[0], v[1]); w.y = pk2(v[2], v[3]);
      *(u32x2*)(p.xb + (size_t)row * DM + i * 256 + lane * 4) = w;
    }
#pragma unroll
    for (int o = 32; o >= 1; o >>= 1) ss += __shfl_xor(ss, o);
    if (lane == 0) p.rs[row] = __builtin_amdgcn_rsqf(ss * (1.f / DM) + 1e-6f);
  }
  transpose_bf16(p.w_in, DM, INW, p.winT, p.norm_gain, lds, bid, nb);
  transpose_bf16(p.w_out, DM, DM, p.woutT, nullptr, lds, bid, nb);
  const int gt = bid * NT + tid, gn = nb * NT;
  for (int i = gt; i < 512 * 64; i += gn) {
    const int c = i >> 6, j = i & 63;
    p.DUt[i] = (u16)pk2(p.decay_up[j * 512 + c], 0.f);
    p.IUt[i] = (u16)pk2(p.iclr_up[j * 512 + c], 0.f);
  }
  for (int i = gt; i < SEQ * 32; i += gn) {
    const int t = i >> 5, f = i & 31;
    const float invf = __builtin_amdgcn_exp2f(-(float)f * (13.287712379549449f / 32.f));
    const float ang = (float)t * invf;
    double rev = (double)ang * 0.15915494309189535;
    rev -= __builtin_rint(rev);
    const float fr = (float)rev;
    p.ctab[i] = __builtin_amdgcn_cosf(fr);
    p.stab[i] = __builtin_amdgcn_sinf(fr);
  }
  for (int i = gt; i < TOK; i += gn) p.ssq[i] = 0.f;
  if (gt < 64) p.qctr[gt] = 0;
  if (gt < 128) p.pcnt[gt] = 0;
}

template <class Epi>
__device__ __forceinline__ void gemm_tile(const u16* __restrict__ A, const u16* __restrict__ Bt, int K, int m0, int n0, int nmax, char* lds, Epi&& epi, int nk_override = 0, bool partial = false) {
  int tid = threadIdx.x;
  asm volatile("" : "+v"(tid));
  const int lane = tid & 63, wave = __builtin_amdgcn_readfirstlane(tid >> 6), l31 = lane & 31, h = lane >> 5;
  const int wr = partial ? ((wave & 3) >> 1) : (wave >> 2);
  const int wc = partial ? ((wave & 1) + 2 * (wave >> 2)) : (wave & 3);
  const bool domma = !partial || wave < 4;
  u16* As0 = (u16*)lds;
  u16* Bs0 = As0 + 2 * 256 * LD;
  f32x16 acc[2][4];
#pragma unroll
  for (int a = 0; a < 2; ++a)
#pragma unroll
    for (int b = 0; b < 4; ++b)
#pragma unroll
      for (int r = 0; r < 16; ++r) acc[a][b][r] = 0.f;
  u32x4 ra[4], rb[4];
  const int srow = tid >> 3, skc = tid & 7;
  const u16* Ag = A + (size_t)(m0 + srow) * K + skc * 8;
  const u16* Bg[4];
#pragma unroll
  for (int i = 0; i < 4; ++i) { int n = n0 + srow + 64 * i; n = n < nmax ? n : nmax - 1; Bg[i] = Bt + (size_t)n * K + skc * 8; }
  const int nk = nk_override ? nk_override : K / 64;
#pragma unroll
  for (int i = 0; i < 4; ++i) { ra[i] = *(const u32x4*)(Ag + (size_t)(64 * i) * K); rb[i] = *(const u32x4*)(Bg[i]); }
#pragma unroll
  for (int i = 0; i < 4; ++i) { *(u32x4*)(As0 + (srow + 64 * i) * LD + skc * 8) = ra[i]; *(u32x4*)(Bs0 + (srow + 64 * i) * LD + skc * 8) = rb[i]; }
  if (nk > 1) {
#pragma unroll
    for (int i = 0; i < 4; ++i) { ra[i] = *(const u32x4*)(Ag + (size_t)(64 * i) * K + 64); rb[i] = *(const u32x4*)(Bg[i] + 64); }
  }
  for (int kt = 0; kt < nk; ++kt) {
    __syncthreads();
    if (kt + 1 < nk) {
      u16* aw = As0 + ((kt + 1) & 1) * 256 * LD;
      u16* bw = Bs0 + ((kt + 1) & 1) * 256 * LD;
#pragma unroll
      for (int i = 0; i < 4; ++i) { *(u32x4*)(aw + (srow + 64 * i) * LD + skc * 8) = ra[i]; *(u32x4*)(bw + (srow + 64 * i) * LD + skc * 8) = rb[i]; }
    }
    if (kt + 2 < nk) {
#pragma unroll
      for (int i = 0; i < 4; ++i) { ra[i] = *(const u32x4*)(Ag + (size_t)(64 * i) * K + (kt + 2) * 64); rb[i] = *(const u32x4*)(Bg[i] + (kt + 2) * 64); }
    }
    __builtin_amdgcn_sched_barrier(0);
    const u16* as = As0 + (kt & 1) * 256 * LD + (wr * 128 + l31) * LD + h * 8;
    const u16* bs = Bs0 + (kt & 1) * 256 * LD + (wc * 64 + l31) * LD + h * 8;
    if (domma)
#pragma unroll
    for (int ks = 0; ks < 4; ++ks) {
      bf16x8 wf[2], xf[4];
#pragma unroll
      for (int ct = 0; ct < 2; ++ct) wf[ct] = *(const bf16x8*)(bs + ct * 32 * LD + ks * 16);
#pragma unroll
      for (int tt = 0; tt < 4; ++tt) xf[tt] = *(const bf16x8*)(as + tt * 32 * LD + ks * 16);
#pragma unroll
      for (int ct = 0; ct < 2; ++ct)
#pragma unroll
        for (int tt = 0; tt < 4; ++tt) acc[ct][tt] = __builtin_amdgcn_mfma_f32_32x32x16_bf16(wf[ct], xf[tt], acc[ct][tt], 0, 0, 0);
    }
    __builtin_amdgcn_sched_barrier(0);
  }
  __syncthreads();
  epi(acc, m0, n0, wr, wc, l31, h);
}

__device__ void phase_gemm1(const Params& p, char* lds, int bid, int nb, int mode = 0) {
  const int tid = threadIdx.x;
  constexpr int NMT = TOK / 256, NNT = (INW + 255) / 256;
  const int xcd = bid & 7, jx = bid >> 3, nbx = (nb + 7 - xcd) >> 3;
  for (int Lx = jx; Lx < (NMT / 8) * NNT; Lx += nbx) {
    const int grp = Lx / (2 * NNT), gi = Lx % (2 * NNT);
    const int mt = xcd * (NMT / 8) + 2 * grp + (gi & 1), nt = gi >> 1;
    gemm_tile(p.xb, p.winT, DM, mt * 256, nt * 256, INW, lds, [&](f32x16 (&acc)[2][4], int m0, int n0, int wr, int wc, int l31, int h) {
      float rsv[4]; int tok[4];
#pragma unroll
      for (int tt = 0; tt < 4; ++tt) { tok[tt] = m0 + wr * 128 + tt * 32 + l31; rsv[tt] = p.rs[tok[tt]]; }
      if (mode == 1) {
        float sacc = 0.f;
#pragma unroll
        for (int ct = 0; ct < 2; ++ct)
#pragma unroll
          for (int tt = 0; tt < 4; ++tt)
#pragma unroll
            for (int r = 0; r < 16; ++r) sacc += acc[ct][tt][r];
        if (sacc == 123.456f) p.rs[tok[0]] = sacc;
        return;
      }
      const int nw = n0 + wc * 64;
      const int lane = h * 32 + l31;
      u16* stg = (u16*)lds + (wr * 4 + wc) * (128 * LD);
      float* red = (float*)(lds + 8 * 128 * LD * 2);
      const int bq = m0 >> 12, pos0 = (m0 & 4095) + wr * 128;
      auto flush_rows = [&](u16* gbase, size_t ldd) {
#pragma unroll
        for (int it = 0; it < 16; ++it) {
          const int r = it * 8 + (lane >> 3), ch = lane & 7;
          *(u32x4*)(gbase + (size_t)r * ldd + ch * 8) = *(const u32x4*)(stg + r * LD + ch * 8);
        }
      };
      if (n0 < 1024) {
        const bool isq = n0 < 512;
        const int head = (nw & 511) >> 6;
        const float osc = isq ? (0.125f * 1.44269504088896f) : 1.f;
        u16* dst = isq ? p.Q : p.K;
        float ksum[2][16];
#pragma unroll
        for (int ct = 0; ct < 2; ++ct)
#pragma unroll
          for (int r = 0; r < 16; ++r) ksum[ct][r] = 0.f;
#pragma unroll
        for (int tt = 0; tt < 4; ++tt) {
          __builtin_amdgcn_sched_barrier(0);
          const int pos = tok[tt] & 4095;
          u16* srow = stg + (tt * 32 + l31) * LD;
#pragma unroll
          for (int rq = 0; rq < 4; ++rq) {
            const int i0 = 8 * rq + 4 * h;
            const f32x4 c4 = *(const f32x4*)(p.ctab + pos * 32 + i0);
            const f32x4 s4 = *(const f32x4*)(p.stab + pos * 32 + i0);
            float y1[4], y2[4];
#pragma unroll
            for (int e = 0; e < 4; ++e) {
              const float x1 = acc[0][tt][rq * 4 + e] * rsv[tt], x2 = acc[1][tt][rq * 4 + e] * rsv[tt];
              y1[e] = (x1 * c4[e] - x2 * s4[e]) * osc;
              y2[e] = (x2 * c4[e] + x1 * s4[e]) * osc;
              ksum[0][rq * 4 + e] += y1[e];
              ksum[1][rq * 4 + e] += y2[e];
            }
            u32x2 w1, w2; w1.x = pk2(y1[0], y1[1]); w1.y = pk2(y1[2], y1[3]); w2.x = pk2(y2[0], y2[1]); w2.y = pk2(y2[2], y2[3]);
            *(u32x2*)(srow + i0) = w1;
            *(u32x2*)(srow + 32 + i0) = w2;
          }
        }
        flush_rows(dst + ((size_t)(bq * 8 + head) * SEQ + pos0) * 64, 64);
        if (!isq) {
#pragma unroll
          for (int ct = 0; ct < 2; ++ct)
#pragma unroll
            for (int r = 0; r < 16; ++r) {
              float v = ksum[ct][r];
              v += __shfl_xor(v, 1); v += __shfl_xor(v, 2); v += __shfl_xor(v, 4); v += __shfl_xor(v, 8); v += __shfl_xor(v, 16);
              if (l31 == 0) red[wr * 256 + wc * 64 + ct * 32 + rm32(r, h)] = v;
            }
        }
        __syncthreads();
        if (!isq && tid < 256) {
          const float sres = red[tid] + red[256 + tid];
          const int blk = (m0 & 4095) >> 8, hd = ((n0 & 511) >> 6) + (tid >> 6);
          p.kmean[((size_t)(bq * 8 + hd) * 16 + blk) * 64 + (tid & 63)] = sres * (1.f / 256.f);
        }
      } else if (nw < 1536) {
        const int head = (nw - 1024) >> 6;
        constexpr int VLD = 136;
#pragma unroll
        for (int tt = 0; tt < 4; ++tt)
#pragma unroll
          for (int ct = 0; ct < 2; ++ct)
#pragma unroll
            for (int r = 0; r < 16; r += 2) {
              const unsigned w = pk2(acc[ct][tt][r] * rsv[tt], acc[ct][tt][r + 1] * rsv[tt]);
              stg[(ct * 32 + rm32(r, h)) * VLD + tt * 32 + l31] = (u16)(w & 0xffffu);
              stg[(ct * 32 + rm32(r + 1, h)) * VLD + tt * 32 + l31] = (u16)(w >> 16);
            }
        u16* gbase = p.Vt + (size_t)(bq * 8 + head) * 64 * SEQ + pos0;
#pragma unroll
        for (int it = 0; it < 16; ++it) {
          const int d = it * 4 + (lane >> 4), ch = lane & 15;
          *(u32x4*)(gbase + (size_t)d * SEQ + ch * 8) = *(const u32x4*)(stg + d * VLD + ch * 8);
        }
      } else if (nw < INW) {
        u16* dst; int ldd, c0; bool act;
        if (nw < 2048) { dst = p.GA; ldd = 512; c0 = nw - 1536; act = true; }
        else if (nw < 3712) { dst = p.PB; ldd = PBW; c0 = nw - 2048; act = false; }
        else { dst = p.GB; ldd = 512; c0 = nw - 3712; act = true; }
#pragma unroll
        for (int tt = 0; tt < 4; ++tt) {
          u16* srow = stg + (tt * 32 + l31) * LD;
#pragma unroll
          for (int ct = 0; ct < 2; ++ct)
#pragma unroll
            for (int rq = 0; rq < 4; ++rq) {
              float v[4];
#pragma unroll
              for (int e = 0; e < 4; ++e) { v[e] = acc[ct][tt][rq * 4 + e] * rsv[tt]; if (act) v[e] = v[e] * fsigmoid(v[e]); }
              u32x2 w; w.x = pk2(v[0], v[1]); w.y = pk2(v[2], v[3]);
              *(u32x2*)(srow + ct * 32 + 8 * rq + 4 * h) = w;
            }
        }
        flush_rows(dst + (size_t)(m0 + wr * 128) * ldd + c0, (size_t)ldd);
      }
      __syncthreads();
    }, mode == 2 ? 1 : 0, nt == NNT - 1);
  }
}

__device__ void phase_gemm2(const Params& p, char* lds, int bid, int nb, bool fused) {
  constexpr int NMT = TOK / 256, NNT = DM / 256;
  const int xcd = bid & 7, jx = bid >> 3, nbx = (nb + 7 - xcd) >> 3;
  for (int Lx = jx; Lx < (NMT / 8) * NNT; Lx += nbx) {
    const int mt = xcd * (NMT / 8) + Lx / NNT, nt = Lx % NNT;
    gemm_tile(p.Ymix, p.woutT, DM, mt * 256, nt * 256, DM, lds, [&](f32x16 (&acc)[2][4], int m0, int n0, int wr, int wc, int l31, int h) {
      float olds[4];
#pragma unroll
      for (int tt = 0; tt < 4; ++tt) {
        const int tok = m0 + wr * 128 + tt * 32 + l31;
        const float* xr = p.x + (size_t)tok * DM + n0 + wc * 64;
        float ss = 0.f;
#pragma unroll
        for (int ct = 0; ct < 2; ++ct)
#pragma unroll
          for (int rq = 0; rq < 4; ++rq) {
            const f32x4 xv = *(const f32x4*)(xr + ct * 32 + 8 * rq + 4 * h);
#pragma unroll
            for (int e = 0; e < 4; ++e) { acc[ct][tt][rq * 4 + e] += xv[e]; ss += acc[ct][tt][rq * 4 + e] * acc[ct][tt][rq * 4 + e]; }
          }
        ss += __shfl_xor(ss, 32);
        olds[tt] = 0.f;
        if (h == 0) olds[tt] = atomicAdd(p.ssq + tok, ss);
      }
      asm volatile("" :: "v"(olds[0]), "v"(olds[1]), "v"(olds[2]), "v"(olds[3]));
      if (fused) {
        __syncthreads();
        if (threadIdx.x == 0) {
          __hip_atomic_fetch_add(p.pcnt + (m0 >> 8), 1, __ATOMIC_RELAXED, __HIP_MEMORY_SCOPE_AGENT);
          while (__hip_atomic_load(p.pcnt + (m0 >> 8), __ATOMIC_RELAXED, __HIP_MEMORY_SCOPE_AGENT) < NNT) __builtin_amdgcn_s_sleep(2);
        }
        __syncthreads();
      }
#pragma unroll
      for (int tt = 0; tt < 4; ++tt) {
        const int tok = m0 + wr * 128 + tt * 32 + l31;
        float sc = 1.f;
        if (fused) sc = __builtin_amdgcn_rsqf(__hip_atomic_load(p.ssq + tok, __ATOMIC_RELAXED, __HIP_MEMORY_SCOPE_AGENT) * (1.f / DM) + 1e-6f);
        float* orow = p.out + (size_t)tok * DM + n0 + wc * 64;
        const float* gr = p.final_gain + n0 + wc * 64;
#pragma unroll
        for (int ct = 0; ct < 2; ++ct)
#pragma unroll
          for (int rq = 0; rq < 4; ++rq) {
            const int c = ct * 32 + 8 * rq + 4 * h;
            f32x4 o;
            if (fused) {
              const f32x4 gv = *(const f32x4*)(gr + c);
#pragma unroll
              for (int e = 0; e < 4; ++e) o[e] = acc[ct][tt][rq * 4 + e] * sc * gv[e];
            } else {
#pragma unroll
              for (int e = 0; e < 4; ++e) o[e] = acc[ct][tt][rq * 4 + e];
            }
            *(f32x4*)(orow + c) = o;
          }
      }
    });
  }
}

__device__ void phase_final(const Params& p, int bid, int nb) {
  const int gt = bid * NT + threadIdx.x, gn = nb * NT;
  for (int i = gt; i < TOK * (DM / 4); i += gn) {
    const int row = i >> 8, c = (i & 255) * 4;
    const float sc = __builtin_amdgcn_rsqf(p.ssq[row] * (1.f / DM) + 1e-6f);
    f32x4 v = *(f32x4*)(p.out + (size_t)row * DM + c);
    const f32x4 g = *(const f32x4*)(p.final_gain + c);
#pragma unroll
    for (int e = 0; e < 4; ++e) v[e] = v[e] * sc * g[e];
    *(f32x4*)(p.out + (size_t)row * DM + c) = v;
  }
}

__device__ void attn_item(const Params& p, char* lds, int bh, int qi) {
  const int tid = threadIdx.x, lane = tid & 63, wave = tid >> 6, l31 = lane & 31, h = lane >> 5;
  u16* Ks = (u16*)lds;
  u16* Vs = Ks + 2 * 64 * LD;
  float* km = (float*)(Vs + 2 * 64 * LD);
  const u16* Qg = p.Q + (size_t)bh * SEQ * 64;
  const u16* Kg = p.K + (size_t)bh * SEQ * 64;
  const u16* Vg = p.Vt + (size_t)bh * 64 * SEQ;
  __syncthreads();
  for (int i = tid; i < 16 * 64; i += NT) km[i] = p.kmean[(size_t)bh * 16 * 64 + i];
  const int qpos = qi * 256 + wave * 32 + l31;
  bf16x8 qf[4];
#pragma unroll
  for (int ks = 0; ks < 4; ++ks) qf[ks] = *(const bf16x8*)(Qg + (size_t)qpos * 64 + ks * 16 + 8 * h);
  __syncthreads();
  unsigned selmask = 0;
  if (qi <= 3) selmask = (1u << qi) - 1u;
  else {
    float v0 = -INFINITY, v1 = -INFINITY, v2 = -INFINITY; int i0 = 0, i1 = 0, i2 = 0;
    for (int j = 0; j < qi; ++j) {
      float g = 0.f;
#pragma unroll
      for (int ks = 0; ks < 4; ++ks) {
        const f32x4 ka = *(const f32x4*)(km + j * 64 + ks * 16 + 8 * h);
        const f32x4 kb = *(const f32x4*)(km + j * 64 + ks * 16 + 8 * h + 4);
#pragma unroll
        for (int e = 0; e < 4; ++e) {
          g += bf2f((unsigned)(u16)qf[ks][e]) * ka[e];
          g += bf2f((unsigned)(u16)qf[ks][4 + e]) * kb[e];
        }
      }
      g += __shfl_xor(g, 32);
      if (g > v0) { v2 = v1; i2 = i1; v1 = v0; i1 = i0; v0 = g; i0 = j; }
      else if (g > v1) { v2 = v1; i2 = i1; v1 = g; i1 = j; }
      else if (g > v2) { v2 = g; i2 = j; }
    }
    selmask = (1u << i0) | (1u << i1) | (1u << i2);
  }
  f32x16 O[2];
#pragma unroll
  for (int d = 0; d < 2; ++d)
#pragma unroll
    for (int r = 0; r < 16; ++r) O[d][r] = 0.f;
  float mref = 0.f, lsum = 0.f;
  bool first = true;
  const int nsteps = (qi + 1) * 4;
  const int skey = tid >> 3, sch = tid & 7;
  u32x4 rk, rv;
  auto gload = [&](int s) {
    const int jb = qi - (s >> 2), sub = s & 3, key0 = jb * 256 + sub * 64;
    rk = *(const u32x4*)(Kg + (size_t)(key0 + skey) * 64 + sch * 8);
    rv = *(const u32x4*)(Vg + (size_t)skey * SEQ + key0 + sch * 8);
  };
  auto swrite = [&](int buf) {
    *(u32x4*)(Ks + buf * 64 * LD + skey * LD + sch * 8) = rk;
    u16* vd = Vs + buf * 64 * LD + skey * LD + 16 * (sch >> 1) + 4 * (sch & 1);
    u32x2 a, b; a.x = rv.x; a.y = rv.y; b.x = rv.z; b.y = rv.w;
    *(u32x2*)(vd) = a;
    *(u32x2*)(vd + 8) = b;
  };
  gload(0); swrite(0);
  __syncthreads();
  auto fast_step = [&](auto diag_, int s, int sub, bool sel) {
    constexpr bool DIAG = decltype(diag_)::value;
    const u16* ks_ = Ks + (s & 1) * 64 * LD + l31 * LD + 8 * h;
    const u16* vs_ = Vs + (s & 1) * 64 * LD + l31 * LD + 8 * h;
    f32x16 cb, S0, S1;
    {
      const float cinit = sel ? -mref : -INFINITY;
#pragma unroll
      for (int r = 0; r < 16; ++r) cb[r] = cinit;
    }
    S0 = __builtin_amdgcn_mfma_f32_32x32x16_bf16(*(const bf16x8*)(ks_), qf[0], cb, 0, 0, 0);
#pragma unroll
    for (int ks = 1; ks < 4; ++ks) S0 = __builtin_amdgcn_mfma_f32_32x32x16_bf16(*(const bf16x8*)(ks_ + ks * 16), qf[ks], S0, 0, 0, 0);
    S1 = __builtin_amdgcn_mfma_f32_32x32x16_bf16(*(const bf16x8*)(ks_ + 32 * LD), qf[0], cb, 0, 0, 0);
#pragma unroll
    for (int ks = 1; ks < 4; ++ks) S1 = __builtin_amdgcn_mfma_f32_32x32x16_bf16(*(const bf16x8*)(ks_ + 32 * LD + ks * 16), qf[ks], S1, 0, 0, 0);
    if constexpr (DIAG) {
      const int qrel = wave * 32 + l31;
#pragma unroll
      for (int r = 0; r < 16; ++r) {
        const int krel = sub * 64 + rm32(r, h);
        S0[r] = (krel <= qrel) ? S0[r] : -INFINITY;
        S1[r] = (krel + 32 <= qrel) ? S1[r] : -INFINITY;
      }
    }
    float mx0 = -INFINITY, mx1 = -INFINITY, ps0 = 0.f, ps1 = 0.f;
#pragma unroll
    for (int r = 0; r < 16; r += 2) mx0 = fmaxf(fmaxf(mx0, S0[r]), S0[r + 1]);
#pragma unroll
    for (int r = 0; r < 16; ++r) { S0[r] = __builtin_amdgcn_exp2f(S0[r]); ps0 += S0[r]; }
#pragma unroll
    for (int sp = 0; sp < 2; ++sp) {
      u32x4 pw;
      pw.x = pk2(S0[8 * sp + 0], S0[8 * sp + 1]); pw.y = pk2(S0[8 * sp + 2], S0[8 * sp + 3]);
      pw.z = pk2(S0[8 * sp + 4], S0[8 * sp + 5]); pw.w = pk2(S0[8 * sp + 6], S0[8 * sp + 7]);
      const bf16x8 pb = __builtin_bit_cast(bf16x8, pw);
#pragma unroll
      for (int d = 0; d < 2; ++d) O[d] = __builtin_amdgcn_mfma_f32_32x32x16_bf16(*(const bf16x8*)(vs_ + d * 32 * LD + sp * 16), pb, O[d], 0, 0, 0);
    }
#pragma unroll
    for (int r = 0; r < 16; r += 2) mx1 = fmaxf(fmaxf(mx1, S1[r]), S1[r + 1]);
#pragma unroll
    for (int r = 0; r < 16; ++r) { S1[r] = __builtin_amdgcn_exp2f(S1[r]); ps1 += S1[r]; }
#pragma unroll
    for (int sp = 0; sp < 2; ++sp) {
      u32x4 pw;
      pw.x = pk2(S1[8 * sp + 0], S1[8 * sp + 1]); pw.y = pk2(S1[8 * sp + 2], S1[8 * sp + 3]);
      pw.z = pk2(S1[8 * sp + 4], S1[8 * sp + 5]); pw.w = pk2(S1[8 * sp + 6], S1[8 * sp + 7]);
      const bf16x8 pb = __builtin_bit_cast(bf16x8, pw);
#pragma unroll
      for (int d = 0; d < 2; ++d) O[d] = __builtin_amdgcn_mfma_f32_32x32x16_bf16(*(const bf16x8*)(vs_ + d * 32 * LD + 32 + sp * 16), pb, O[d], 0, 0, 0);
    }
    lsum += ps0 + ps1;
#if ATTN_SGB
    __builtin_amdgcn_sched_group_barrier(0x008, 4, 0);
#pragma unroll
    for (int i = 0; i < 4; ++i) { __builtin_amdgcn_sched_group_barrier(0x008, 1, 0); __builtin_amdgcn_sched_group_barrier(0x002, 12, 0); }
#pragma unroll
    for (int i = 0; i < 4; ++i) { __builtin_amdgcn_sched_group_barrier(0x008, 1, 0); __builtin_amdgcn_sched_group_barrier(0x002, 12, 0); }
    __builtin_amdgcn_sched_group_barrier(0x008, 4, 0);
#endif
    float mx = fmaxf(mx0, mx1);
    mx = fmaxf(mx, __shfl_xor(mx, 32));
    if (__ballot(mx > 8.f) != 0ull) {
      const float delta = (mx > 8.f) ? mx : 0.f;
      const float alpha = __builtin_amdgcn_exp2f(-delta);
      mref += delta;
      lsum *= alpha;
#pragma unroll
      for (int d = 0; d < 2; ++d)
#pragma unroll
        for (int r = 0; r < 16; ++r) O[d][r] *= alpha;
    }
  };
  for (int s = 0; s < nsteps; ++s) {
    if (s + 1 < nsteps) gload(s + 1);
    const int jb = qi - (s >> 2), sub = s & 3;
    const bool own = (s < 4);
    const bool sel = own ? true : ((selmask >> jb) & 1u);
    bool active;
    if (own) active = (sub * 64 <= wave * 32 + 31);
    else active = (__ballot(sel) != 0ull);
    if (active && s > 0) {
      if (own && (sub * 64 + 63 > wave * 32)) fast_step(std::true_type{}, s, sub, sel);
      else fast_step(std::false_type{}, s, sub, sel);
    } else if (active) {
      const u16* ks_ = Ks + (s & 1) * 64 * LD + l31 * LD + 8 * h;
      const u16* vs_ = Vs + (s & 1) * 64 * LD + l31 * LD + 8 * h;
      f32x16 S[2], cb;
      {
        const float cinit = sel ? -mref : -INFINITY;
#pragma unroll
        for (int r = 0; r < 16; ++r) cb[r] = cinit;
      }
#pragma unroll
      for (int kt = 0; kt < 2; ++kt) {
        {
          const bf16x8 kf = *(const bf16x8*)(ks_ + kt * 32 * LD);
          S[kt] = __builtin_amdgcn_mfma_f32_32x32x16_bf16(kf, qf[0], cb, 0, 0, 0);
        }
#pragma unroll
        for (int ks = 1; ks < 4; ++ks) {
          const bf16x8 kf = *(const bf16x8*)(ks_ + kt * 32 * LD + ks * 16);
          S[kt] = __builtin_amdgcn_mfma_f32_32x32x16_bf16(kf, qf[ks], S[kt], 0, 0, 0);
        }
      }
      const int qrel = wave * 32 + l31;
      if (own && (sub * 64 + 63 > wave * 32)) {
#pragma unroll
        for (int kt = 0; kt < 2; ++kt)
#pragma unroll
          for (int r = 0; r < 16; ++r) {
            const int krel = sub * 64 + kt * 32 + rm32(r, h);
            S[kt][r] = (krel <= qrel) ? S[kt][r] : -INFINITY;
          }
      }
      float mx = -INFINITY;
#pragma unroll
      for (int kt = 0; kt < 2; ++kt)
#pragma unroll
        for (int r = 0; r < 16; r += 2) mx = fmaxf(fmaxf(mx, S[kt][r]), S[kt][r + 1]);
      mx = fmaxf(mx, __shfl_xor(mx, 32));
      const bool need = first || (mx > 8.f);
      if (__ballot(need) != 0ull) {
        const float delta = need ? mx : 0.f;
        mref += delta;
#pragma unroll
        for (int kt = 0; kt < 2; ++kt)
#pragma unroll
          for (int r = 0; r < 16; ++r) S[kt][r] -= delta;
        if (!first) {
          const float alpha = __builtin_amdgcn_exp2f(-delta);
          lsum *= alpha;
#pragma unroll
          for (int d = 0; d < 2; ++d)
#pragma unroll
            for (int r = 0; r < 16; ++r) O[d][r] *= alpha;
        }
      }
      first = false;
      float ps = 0.f;
#pragma unroll
      for (int kt = 0; kt < 2; ++kt)
#pragma unroll
        for (int r = 0; r < 16; ++r) { S[kt][r] = __builtin_amdgcn_exp2f(S[kt][r]); ps += S[kt][r]; }
      lsum += ps;
#pragma unroll
      for (int kt = 0; kt < 2; ++kt)
#pragma unroll
        for (int sp = 0; sp < 2; ++sp) {
          u32x4 pw;
          pw.x = pk2(S[kt][8 * sp + 0], S[kt][8 * sp + 1]); pw.y = pk2(S[kt][8 * sp + 2], S[kt][8 * sp + 3]);
          pw.z = pk2(S[kt][8 * sp + 4], S[kt][8 * sp + 5]); pw.w = pk2(S[kt][8 * sp + 6], S[kt][8 * sp + 7]);
          const bf16x8 pb = __builtin_bit_cast(bf16x8, pw);
#pragma unroll
          for (int d = 0; d < 2; ++d) {
            const bf16x8 vf = *(const bf16x8*)(vs_ + d * 32 * LD + kt * 32 + sp * 16);
            O[d] = __builtin_amdgcn_mfma_f32_32x32x16_bf16(vf, pb, O[d], 0, 0, 0);
          }
        }
    }
    if (s + 1 < nsteps) swrite((s + 1) & 1);
    __syncthreads();
  }
  lsum += __shfl_xor(lsum, 32);
  const float inv = __builtin_amdgcn_rcpf(lsum);
  const int b = bh >> 3, hd = bh & 7;
  const size_t tok = (size_t)b * SEQ + qpos;
  const u16* ga = p.GA + tok * 512 + hd * 64;
  u16* yo = p.Ymix + tok * 1024 + hd * 64;
#pragma unroll
  for (int d = 0; d < 2; ++d)
#pragma unroll
    for (int rq = 0; rq < 4; ++rq) {
      const int c = d * 32 + 8 * rq + 4 * h;
      const u32x2 g = *(const u32x2*)(ga + c);
      u32x2 w;
      w.x = pk2(O[d][rq * 4 + 0] * inv * bflo(g.x), O[d][rq * 4 + 1] * inv * bfhi(g.x));
      w.y = pk2(O[d][rq * 4 + 2] * inv * bflo(g.y), O[d][rq * 4 + 3] * inv * bfhi(g.y));
      *(u32x2*)(yo + c) = w;
    }
}

template <bool SWA = false, bool SWB = false>
__device__ __forceinline__ void mm_nt(const u16* A, const u16* B, f32x4 (&acc)[2], int wave, int lane) {
  const int it = wave >> 1, jt0 = (wave & 1) * 2, r = lane & 15, g = lane >> 4;
#pragma unroll
  for (int ks = 0; ks < 2; ++ks) {
    const int ra = it * 16 + r;
    const int cha = SWA ? ((ks * 4 + g) ^ ((ra >> 3) & 7)) : (ks * 4 + g);
    const bf16x8 bfr = *(const bf16x8*)(A + ra * LD + cha * 8);
#pragma unroll
    for (int jj = 0; jj < 2; ++jj) {
      const int rb = (jt0 + jj) * 16 + r;
      const int chb = SWB ? ((ks * 4 + g) ^ ((rb >> 3) & 7)) : (ks * 4 + g);
      const bf16x8 afr = *(const bf16x8*)(B + rb * LD + chb * 8);
      acc[jj] = __builtin_amdgcn_mfma_f32_16x16x32_bf16(afr, bfr, acc[jj], 0, 0, 0);
    }
  }
}
__device__ __forceinline__ void zero2(f32x4 (&a)[2]) {
#pragma unroll
  for (int j = 0; j < 2; ++j)
#pragma unroll
    for (int e = 0; e < 4; ++e) a[j][e] = 0.f;
}

struct PrepRaw { u32x4 cur[5]; };
__device__ __forceinline__ void prep_load(const Params& p, int item, PrepRaw& rw) {
  const int tid = threadIdx.x;
  const int b = item >> 9, hd = (item >> 6) & 7, c = item & 63;
  const int t = tid >> 3, cg8 = (tid & 7) * 8;
  const u16* prow = p.PB + ((size_t)b * SEQ + c * 64 + t) * PBW;
  rw.cur[0] = *(const u32x4*)(prow + hd * 64 + cg8);
  rw.cur[1] = *(const u32x4*)(prow + 512 + hd * 64 + cg8);
  rw.cur[2] = *(const u32x4*)(prow + 1024 + hd * 64 + cg8);
  rw.cur[3] = *(const u32x4*)(prow + 1536 + cg8);
  rw.cur[4] = *(const u32x4*)(prow + 1600 + cg8);
}
__device__ void rwkv_prep_item(const Params& p, char* lds_, int item, PrepRaw& raw, int next_item) {
  char* lds = lds_ + 256;
  const int tid = threadIdx.x, lane = tid & 63, wave = tid >> 6;
  const int b = item >> 9, hd = (item >> 6) & 7, c = item & 63;
  constexpr int RB = 64 * LD * 2;
  u16* At = (u16*)(lds + 0 * RB);  u16* Bt = (u16*)(lds + 1 * RB);  u16* Kt = (u16*)(lds + 2 * RB);  u16* Rt = (u16*)(lds + 3 * RB);
  u16* AT = (u16*)(lds + 4 * RB);  u16* BT = (u16*)(lds + 5 * RB);  u16* KT = (u16*)(lds + 6 * RB);  u16* VT = (u16*)(lds + 7 * RB);
  u16* LAK = (u16*)(lds + 8 * RB); u16* MRB = (u16*)(lds + 9 * RB); u16* MRK = (u16*)(lds + 10 * RB); u16* TB = (u16*)(lds + 11 * RB);
  float* Tf = (float*)(lds + 12 * RB);
  float* gC = (float*)(lds + 12 * RB + 64 * 68 * 4);
  float* Za = (float*)(lds + 12 * RB + 64 * 68 * 4 + 256);
  u16* X1T = At; u16* WT = Bt; u16* U0T = Kt;
  u16* TW = LAK; u16* AD = MRB; u16* DUs = MRK; u16* IUs = TB;
  float* Zw = Tf; float* G = Tf;

  const int t = tid >> 3, cg8 = (tid & 7) * 8;
  const int pos = c * 64 + t;
  const size_t tokrow = (size_t)b * SEQ + pos;
  const u16* prow = p.PB + tokrow * PBW;
  const bool hasprev = pos > 0;
  float rr[8], kk_[8], vv[8];
  f32x4 pdb[2], pib[2], pkk[2], pka[2], prk[2];
  {
    const int cbp = hd * 64 + cg8;
#pragma unroll
    for (int q = 0; q < 2; ++q) {
      pdb[q] = *(const f32x4*)(p.decay_bias + cbp + 4 * q); pib[q] = *(const f32x4*)(p.iclr_bias + cbp + 4 * q);
      pkk[q] = *(const f32x4*)(p.k_k + cbp + 4 * q); pka[q] = *(const f32x4*)(p.k_a + cbp + 4 * q); prk[q] = *(const f32x4*)(p.r_k + cbp + 4 * q);
    }
  }
  __syncthreads();
  {
    auto ldshift = [&](int col, float (&o)[8], const u32x4 cur) {
      u32x4 prv; prv.x = prv.y = prv.z = prv.w = 0u;
      if (hasprev) prv = *(const u32x4*)(prow - PBW + col);
      const f32x4 m0 = *(const f32x4*)(p.shift_mu + col), m1 = *(const f32x4*)(p.shift_mu + col + 4);
      const unsigned cw[4] = {cur.x, cur.y, cur.z, cur.w}, pw[4] = {prv.x, prv.y, prv.z, prv.w};
#pragma unroll
      for (int q = 0; q < 4; ++q) {
        const float c0 = bflo(cw[q]), c1 = bfhi(cw[q]), p0 = bflo(pw[q]), p1 = bfhi(pw[q]);
        const float mu0 = (q < 2) ? m0[2 * q] : m1[2 * q - 4], mu1 = (q < 2) ? m0[2 * q + 1] : m1[2 * q - 3];
        o[2 * q] = c0 + (p0 - c0) * mu0;
        o[2 * q + 1] = c1 + (p1 - c1) * mu1;
      }
    };
    ldshift(hd * 64 + cg8, rr, raw.cur[0]);
    ldshift(512 + hd * 64 + cg8, kk_, raw.cur[1]);
    ldshift(1024 + hd * 64 + cg8, vv, raw.cur[2]);
    float wd[8], ad[8];
    ldshift(1536 + cg8, wd, raw.cur[3]);
    ldshift(1600 + cg8, ad, raw.cur[4]);
    u32x4 w;
    float th[8];
#pragma unroll
    for (int e = 0; e < 8; ++e) th[e] = 1.f - 2.f * __builtin_amdgcn_rcpf(1.f + fexp(2.f * wd[e]));
    w.x = pk2(th[0], th[1]); w.y = pk2(th[2], th[3]); w.z = pk2(th[4], th[5]); w.w = pk2(th[6], th[7]);
    *(u32x4*)(TW + t * LD + cg8) = w;
    w.x = pk2(ad[0], ad[1]); w.y = pk2(ad[2], ad[3]); w.z = pk2(ad[4], ad[5]); w.w = pk2(ad[6], ad[7]);
    *(u32x4*)(AD + t * LD + cg8) = w;
    *(u32x4*)(DUs + t * LD + cg8) = *(const u32x4*)(p.DUt + (size_t)(hd * 64 + t) * 64 + cg8);
    *(u32x4*)(IUs + t * LD + cg8) = *(const u32x4*)(p.IUt + (size_t)(hd * 64 + t) * 64 + cg8);
  }
  __syncthreads();
  const int it = wave >> 1, jt0 = (wave & 1) * 2, mr = lane & 15, mg = lane >> 4;
  const int mi = it * 16 + mr;
  {
    f32x4 a1[2], a2[2]; zero2(a1); zero2(a2);
    mm_nt(TW, DUs, a1, wave, lane);
    mm_nt(AD, IUs, a2, wave, lane);
#pragma unroll
    for (int jj = 0; jj < 2; ++jj) {
      *(f32x4*)(Zw + mi * 68 + (jt0 + jj) * 16 + 4 * mg) = a1[jj];
      *(f32x4*)(Za + mi * 68 + (jt0 + jj) * 16 + 4 * mg) = a2[jj];
    }
  }
  __syncthreads();
  float av[8], bv[8], k2[8], lw[8];
  float bon;
  {
    float ss = 0.f; bon = 0.f;
    float kk[8], ai[8];
#pragma unroll
    for (int e = 0; e < 8; ++e) {
      const float zw = Zw[t * 68 + cg8 + e] + pdb[e >> 2][e & 3];
      const float za = Za[t * 68 + cg8 + e] + pib[e >> 2][e & 3];
      lw[e] = -0.6065306597126334f * fsigmoid(zw);
      ai[e] = fsigmoid(za);
      kk[e] = kk_[e] * pkk[e >> 2][e & 3];
      k2[e] = kk_[e] * (1.f + (ai[e] - 1.f) * pka[e >> 2][e & 3]);
      ss += kk[e] * kk[e];
      bon += rr[e] * k2[e] * prk[e >> 2][e & 3];
    }
    ss += __shfl_xor(ss, 1); ss += __shfl_xor(ss, 2); ss += __shfl_xor(ss, 4);
    bon += __shfl_xor(bon, 1); bon += __shfl_xor(bon, 2); bon += __shfl_xor(bon, 4);
    const float inv = __builtin_amdgcn_rsqf(fmaxf(ss, 1e-24f));
#pragma unroll
    for (int e = 0; e < 8; ++e) { const float kn = kk[e] * inv; av[e] = -kn; bv[e] = kn * ai[e]; }
  }
  __builtin_amdgcn_sched_barrier(0);
  if (next_item < 4096) prep_load(p, next_item, raw);
  __builtin_amdgcn_sched_barrier(0);
  __syncthreads();
#pragma unroll
  for (int e = 0; e < 8; ++e) G[t * 68 + cg8 + e] = lw[e];
  __syncthreads();
  {
    const int d = tid & 63, seg = tid >> 6;
    float s = 0.f;
#pragma unroll
    for (int q = 0; q < 8; ++q) s += G[(seg * 8 + q) * 68 + d];
    Za[seg * 64 + d] = s;
  }
  __syncthreads();
  {
    const int d = tid & 63, seg = tid >> 6;
    float pre = 0.f;
    for (int q = 0; q < seg; ++q) pre += Za[q * 64 + d];
#pragma unroll
    for (int q = 0; q < 8; ++q) { pre += G[(seg * 8 + q) * 68 + d]; G[(seg * 8 + q) * 68 + d] = pre; }
  }
  __syncthreads();
  {
    float a_[8], b_[8], k_[8], r_[8];
#pragma unroll
    for (int e = 0; e < 8; ++e) {
      const float g = G[t * 68 + cg8 + e];
      const float eg = fexp(g), egm = fexp(g - lw[e]), ei = fexp(-g);
      a_[e] = av[e] * egm; b_[e] = bv[e] * ei; k_[e] = k2[e] * ei; r_[e] = rr[e] * eg;
      if (t == 63) gC[cg8 + e] = eg;
    }
    auto put = [&](u16* rowm, u16* trans, const float (&f)[8]) {
      const unsigned wv[4] = {pk2(f[0], f[1]), pk2(f[2], f[3]), pk2(f[4], f[5]), pk2(f[6], f[7])};
      if (rowm) { u32x4 w4; w4.x = wv[0]; w4.y = wv[1]; w4.z = wv[2]; w4.w = wv[3]; *(u32x4*)(rowm + t * LD + cg8) = w4; }
      if (trans) {
#pragma unroll
        for (int e = 0; e < 8; ++e) trans[(cg8 + e) * LD + (((t >> 3) ^ (cg8 >> 3)) << 3) + (t & 7)] = (u16)((e & 1) ? (wv[e >> 1] >> 16) : (wv[e >> 1] & 0xffffu));
      }
    };
    put(At, AT, a_); put(Bt, BT, b_); put(Kt, KT, k_); put(Rt, nullptr, r_); put(nullptr, VT, vv);
    u32x4 w;
    w.x = pk2(bon * vv[0], bon * vv[1]); w.y = pk2(bon * vv[2], bon * vv[3]); w.z = pk2(bon * vv[4], bon * vv[5]); w.w = pk2(bon * vv[6], bon * vv[7]);
    *(u32x4*)(p.BV + (size_t)item * 4096 + t * 64 + cg8) = w;
  }
  __syncthreads();
  {
    f32x4 lab[2], lak[2], mrb[2], mrk[2]; zero2(lab); zero2(lak); zero2(mrb); zero2(mrk);
    mm_nt(At, Bt, lab, wave, lane);
    mm_nt(At, Kt, lak, wave, lane);
    mm_nt(Rt, Bt, mrb, wave, lane);
    mm_nt(Rt, Kt, mrk, wave, lane);
#pragma unroll
    for (int jj = 0; jj < 2; ++jj) {
      const int j0 = (jt0 + jj) * 16 + 4 * mg;
      f32x4 o; float x1[4], x2[4], x3[4];
#pragma unroll
      for (int e = 0; e < 4; ++e) {
        const int j = j0 + e;
        o[e] = (j < mi) ? lab[jj][e] : 0.f;
        x1[e] = (j < mi) ? lak[jj][e] : 0.f;
        x2[e] = (j <= mi) ? mrb[jj][e] : 0.f;
        x3[e] = (j <= mi) ? mrk[jj][e] : 0.f;
      }
      *(f32x4*)(Tf + mi * 68 + j0) = o;
      u32x2 w;
      w.x = pk2(x1[0], x1[1]); w.y = pk2(x1[2], x1[3]); *(u32x2*)(LAK + mi * LD + j0) = w;
      w.x = pk2(x2[0], x2[1]); w.y = pk2(x2[2], x2[3]); *(u32x2*)(MRB + mi * LD + j0) = w;
      w.x = pk2(x3[0], x3[1]); w.y = pk2(x3[2], x3[3]); *(u32x2*)(MRK + mi * LD + j0) = w;
    }
  }
  __syncthreads();
  {
    float* Ms = Za;
    const int r16 = lane & 15, g4 = lane >> 4;
    if (wave == 0) {
      const float* Lk = Tf + (16 * g4) * 68 + 16 * g4;
      float xv[16];
      f32x4 Lc[4], Ln[4];
#pragma unroll
      for (int q = 0; q < 4; ++q) { Lc[q] = (f32x4){0.f, 0.f, 0.f, 0.f}; Ln[q] = Lc[q]; }
#pragma unroll
      for (int i = 0; i < 16; ++i) {
        if (i + 1 < 16) {
#pragma unroll
          for (int q = 0; q < (i + 1 + 3) / 4; ++q) Ln[q] = *(const f32x4*)(Lk + (i + 1) * 68 + 4 * q);
        }
        float s0 = (i == r16) ? 1.f : 0.f, s1 = 0.f;
#pragma unroll
        for (int j = 0; j < i; ++j) {
          if (j & 1) s1 += Lc[j >> 2][j & 3] * xv[j]; else s0 += Lc[j >> 2][j & 3] * xv[j];
        }
        xv[i] = s0 + s1;
#pragma unroll
        for (int q = 0; q < 4; ++q) Lc[q] = Ln[q];
      }
      float* Dk = Tf + (16 * g4) * 68 + 16 * g4 + r16;
#pragma unroll
      for (int i = 0; i < 16; ++i) Dk[i * 68] = xv[i];
    }
    __syncthreads();
    if (wave < 2) {
      const int R = 32 * wave + 16, C = 32 * wave;
      f32x4 m = {0.f, 0.f, 0.f, 0.f};
#pragma unroll
      for (int ks = 0; ks < 4; ++ks)
        m = __builtin_amdgcn_mfma_f32_16x16x4f32(Tf[(R + r16) * 68 + C + 4 * ks + g4], Tf[(C + 4 * ks + g4) * 68 + C + r16], m, 0, 0, 0);
      float* mw = Ms + wave * 16 * 17;
#pragma unroll
      for (int e = 0; e < 4; ++e) mw[(4 * g4 + e) * 17 + r16] = m[e];
      f32x4 t = {0.f, 0.f, 0.f, 0.f};
#pragma unroll
      for (int ks = 0; ks < 4; ++ks)
        t = __builtin_amdgcn_mfma_f32_16x16x4f32(Tf[(R + r16) * 68 + R + 4 * ks + g4], mw[(4 * ks + g4) * 17 + r16], t, 0, 0, 0);
#pragma unroll
      for (int e = 0; e < 4; ++e) Tf[(R + 4 * g4 + e) * 68 + C + r16] = t[e];
    }
    __syncthreads();
    float* M2 = Ms + 2 * 16 * 17;
    const int ti = (wave >> 1) & 1, tj = wave & 1;
    if (wave < 4) {
      f32x4 m = {0.f, 0.f, 0.f, 0.f};
#pragma unroll
      for (int ks = 0; ks < 8; ++ks)
        m = __builtin_amdgcn_mfma_f32_16x16x4f32(Tf[(32 + 16 * ti + r16) * 68 + 4 * ks + g4], Tf[(4 * ks + g4) * 68 + 16 * tj + r16], m, 0, 0, 0);
#pragma unroll
      for (int e = 0; e < 4; ++e) M2[(16 * ti + 4 * g4 + e) * 33 + 16 * tj + r16] = m[e];
    }
    __syncthreads();
    if (wave < 4) {
      f32x4 t = {0.f, 0.f, 0.f, 0.f};
#pragma unroll
      for (int ks = 0; ks < 8; ++ks)
        t = __builtin_amdgcn_mfma_f32_16x16x4f32(Tf[(32 + 16 * ti + r16) * 68 + 32 + 4 * ks + g4], M2[(4 * ks + g4) * 33 + 16 * tj + r16], t, 0, 0, 0);
#pragma unroll
      for (int e = 0; e < 4; ++e) Tf[(32 + 16 * ti + 4 * g4 + e) * 68 + 16 * tj + r16] = t[e];
    }
    __syncthreads();
    {
      const float* tr = Tf + t * 68 + cg8;
      u32x4 w; w.x = pk2(tr[0], tr[1]); w.y = pk2(tr[2], tr[3]); w.z = pk2(tr[4], tr[5]); w.w = pk2(tr[6], tr[7]);
      *(u32x4*)(TB + t * LD + cg8) = w;
    }
  }
  __syncthreads();
  {
    f32x4 a1[2], a2[2]; zero2(a1); zero2(a2);
    mm_nt<true, false>(VT, LAK, a1, wave, lane);
    mm_nt<true, false>(AT, TB, a2, wave, lane);
#pragma unroll
    for (int jj = 0; jj < 2; ++jj) {
      const int j0 = (jt0 + jj) * 16 + 4 * mg;
      u32x2 w;
      w.x = pk2(a1[jj][0], a1[jj][1]); w.y = pk2(a1[jj][2], a1[jj][3]); *(u32x2*)(X1T + mi * LD + j0) = w;
      w.x = pk2(a2[jj][0], a2[jj][1]); w.y = pk2(a2[jj][2], a2[jj][3]); *(u32x2*)(WT + mi * LD + j0) = w;
    }
  }
  __syncthreads();
  {
    f32x4 a1[2]; zero2(a1);
    mm_nt(X1T, TB, a1, wave, lane);
#pragma unroll
    for (int jj = 0; jj < 2; ++jj) {
      const int j0 = (jt0 + jj) * 16 + 4 * mg;
      u32x2 w; w.x = pk2(a1[jj][0], a1[jj][1]); w.y = pk2(a1[jj][2], a1[jj][3]); *(u32x2*)(U0T + mi * LD + j0) = w;
    }
  }
  __syncthreads();
  {
    f32x4 pp[2], qt[2], ry[2], y0[2]; zero2(pp); zero2(qt); zero2(ry); zero2(y0);
    mm_nt<true, false>(BT, WT, pp, wave, lane);
    mm_nt<false, true>(U0T, BT, qt, wave, lane); mm_nt<true, true>(VT, KT, qt, wave, lane);
    mm_nt(MRB, WT, ry, wave, lane);
#if DBG_Y0 == 1
    mm_nt<false, true>(MRK, VT, y0, wave, lane);
#elif DBG_Y0 == 2
    mm_nt(MRB, U0T, y0, wave, lane);
#elif DBG_Y0 == 5
    mm_nt(MRB, X1T, y0, wave, lane);
#elif DBG_Y0 == 3
    mm_nt(MRB, VT, y0, wave, lane);
#elif DBG_Y0 == 4
    mm_nt(MRK, U0T, y0, wave, lane);
#else
    mm_nt(MRB, U0T, y0, wave, lane); mm_nt<false, true>(MRK, VT, y0, wave, lane);
#endif
    const float gci = gC[mi];
#pragma unroll
    for (int jj = 0; jj < 2; ++jj) {
      const int jt = jt0 + jj, j0 = jt * 16 + 4 * mg;
      float pv[4];
#pragma unroll
      for (int e = 0; e < 4; ++e) pv[e] = gci * (pp[jj][e] + ((j0 + e) == mi ? 1.f : 0.f));
      u32x2 w; w.x = pk2(pv[0], pv[1]); w.y = pk2(pv[2], pv[3]);
      *(u32x2*)(p.Pm + (size_t)item * 4096 + mi * 64 + (jt >> 1) * 32 + 8 * mg + 4 * (jt & 1)) = w;
      const f32x4 gj = *(const f32x4*)(gC + j0);
      { u32x2 qw; qw.x = pk2(qt[jj][0] * gj[0], qt[jj][1] * gj[1]); qw.y = pk2(qt[jj][2] * gj[2], qt[jj][3] * gj[3]);
        *(u32x2*)(p.QT + (size_t)item * 4096 + mi * 64 + j0) = qw; }
      const u32x2 rw = *(const u32x2*)(Rt + mi * LD + j0);
      w.x = pk2(ry[jj][0] + bflo(rw.x), ry[jj][1] + bfhi(rw.x)); w.y = pk2(ry[jj][2] + bflo(rw.y), ry[jj][3] + bfhi(rw.y));
      *(u32x2*)(p.Ry + (size_t)item * 4096 + mi * 64 + j0) = w;
#if DBG_DUMP
      { const u32x2 dw = *(const u32x2*)(DBG_DUMP_SRC + mi * LD + j0); y0[jj][0] = bflo(dw.x); y0[jj][1] = bfhi(dw.x); y0[jj][2] = bflo(dw.y); y0[jj][3] = bfhi(dw.y); }
#endif
      { u32x2 yw; yw.x = pk2(y0[jj][0], y0[jj][1]); yw.y = pk2(y0[jj][2], y0[jj][3]);
        *(u32x2*)(p.Y0 + (size_t)item * 4096 + mi * 64 + j0) = yw; }
    }
  }
}

__device__ void phase_mix(const Params& p, char* lds, int bid, int nb) {
  PrepRaw raw;
  if (bid < 4096) prep_load(p, bid, raw);
  for (int item = bid; item < 4096; item += nb) rwkv_prep_item(p, lds, item, raw, item + nb);
}
__device__ void phase_attn_queue(const Params& p, char* lds, int bid, int nb) {
  int* slot = (int*)(lds + LDS_BYTES - 16);
  const int xcd = bid & 7;
  for (;;) {
    __syncthreads();
    if (threadIdx.x == 0) *slot = atomicAdd(p.qctr + xcd * 8, 1);
    __syncthreads();
    const int idx = *slot;
    if (idx >= 128) break;
    const int qi = 15 - (idx >> 3), bh = (idx & 7) * 8 + xcd;
    attn_item(p, lds, bh, qi);
  }
}

__device__ void phase_attn_only(const Params& p, char* lds, int bid, int nb) {
  for (int L = bid; L < 1024; L += nb) {
    const int round = L >> 8, pos = L & 255, grp = pos >> 6, bh = pos & 63;
    const int qi = (round == 0) ? 15 - grp : (round == 1) ? 8 + grp : (round == 2) ? 7 - grp : grp;
    attn_item(p, lds, bh, qi);
  }
}
__device__ void phase_prep_only(const Params& p, char* lds, int bid, int nb) {
  PrepRaw raw;
  if (bid < 4096) prep_load(p, bid, raw);
  for (int item = bid; item < 4096; item += nb) rwkv_prep_item(p, lds, item, raw, item + nb);
}
__device__ void phase_scan(const Params& p, int bid, int nb) {
  const int tid = threadIdx.x, lane = tid & 63, wave = tid >> 6;
  const int r = lane & 15, g = lane >> 4;
  const int nsb = nb < 32 ? nb : 32;
  if (bid >= nsb) return;
  for (int chain = bid * 8 + wave; chain < 256; chain += nsb * 8) {
    const int bh = chain >> 2, v0 = (chain & 3) * 16;
    f32x4 acc[4];
#pragma unroll
    for (int m = 0; m < 4; ++m)
#pragma unroll
      for (int e = 0; e < 4; ++e) acc[m][e] = 0.f;
    struct Buf { bf16x8 pf[4][2]; u32x2 qv[4]; };
    Buf b0, b1, b2;
    auto loadc = [&](Buf& bb, int c) {
      const size_t item = (size_t)bh * 64 + c;
#pragma unroll
      for (int m = 0; m < 4; ++m) {
#pragma unroll
        for (int ks = 0; ks < 2; ++ks) bb.pf[m][ks] = *(const bf16x8*)(p.Pm + item * 4096 + (m * 16 + r) * 64 + ks * 32 + g * 8);
        bb.qv[m] = *(const u32x2*)(p.QT + item * 4096 + (v0 + r) * 64 + m * 16 + 4 * g);
      }
    };
    auto step = [&](const Buf& bb, int c) {
      const size_t item = (size_t)bh * 64 + c;
      bf16x8 hb[2];
#pragma unroll
      for (int ks = 0; ks < 2; ++ks) {
        u32x4 w;
        w.x = pk2(acc[2 * ks][0], acc[2 * ks][1]); w.y = pk2(acc[2 * ks][2], acc[2 * ks][3]);
        w.z = pk2(acc[2 * ks + 1][0], acc[2 * ks + 1][1]); w.w = pk2(acc[2 * ks + 1][2], acc[2 * ks + 1][3]);
        hb[ks] = __builtin_bit_cast(bf16x8, w);
        u32x2 lo, hi; lo.x = w.x; lo.y = w.y; hi.x = w.z; hi.y = w.w;
        *(u32x2*)(p.Hs + item * 4096 + (v0 + r) * 64 + (2 * ks) * 16 + 4 * g) = lo;
        *(u32x2*)(p.Hs + item * 4096 + (v0 + r) * 64 + (2 * ks + 1) * 16 + 4 * g) = hi;
      }
#pragma unroll
      for (int m = 0; m < 4; ++m) {
        acc[m][0] = bflo(bb.qv[m].x); acc[m][1] = bfhi(bb.qv[m].x); acc[m][2] = bflo(bb.qv[m].y); acc[m][3] = bfhi(bb.qv[m].y);
#pragma unroll
        for (int ks = 0; ks < 2; ++ks) acc[m] = __builtin_amdgcn_mfma_f32_16x16x32_bf16(bb.pf[m][ks], hb[ks], acc[m], 0, 0, 0);
      }
    };
    loadc(b0, 0); loadc(b1, 1);
    for (int c = 0; c < 63; c += 3) {
      loadc(b2, c + 2); __builtin_amdgcn_sched_barrier(0);
      step(b0, c); __builtin_amdgcn_sched_barrier(0);
      loadc(b0, c + 3); __builtin_amdgcn_sched_barrier(0);
      step(b1, c + 1); __builtin_amdgcn_sched_barrier(0);
      if (c + 4 < 64) loadc(b1, c + 4);
      __builtin_amdgcn_sched_barrier(0);
      step(b2, c + 2); __builtin_amdgcn_sched_barrier(0);
    }
    step(b0, 63);
  }
}

__device__ void phase_rwkv_out(const Params& p, int bid, int nb) {
  const int tid = threadIdx.x, lane = tid & 63, wave = tid >> 6;
  const int r = lane & 15, g = lane >> 4, wq = wave & 3;
  for (int it2 = bid; it2 < 2048; it2 += nb) {
    const int item = it2 * 2 + (wave >> 2);
    const int b = item >> 9, hd = (item >> 6) & 7, c = item & 63;
    const int tl = wq * 16 + r;
    const u16* ryp = p.Ry + (size_t)item * 4096 + tl * 64;
    const u16* hsp = p.Hs + (size_t)item * 4096;
    f32x4 acc[4];
#pragma unroll
    for (int jt = 0; jt < 4; ++jt) { const u32x2 yw = *(const u32x2*)(p.Y0 + (size_t)item * 4096 + tl * 64 + jt * 16 + 4 * g); acc[jt][0] = bflo(yw.x); acc[jt][1] = bfhi(yw.x); acc[jt][2] = bflo(yw.y); acc[jt][3] = bfhi(yw.y); }
#pragma unroll
    for (int ks = 0; ks < 2; ++ks) {
      const bf16x8 bfr = *(const bf16x8*)(ryp + ks * 32 + g * 8);
#pragma unroll
      for (int jt = 0; jt < 4; ++jt) {
        const bf16x8 afr = *(const bf16x8*)(hsp + (jt * 16 + r) * 64 + ks * 32 + g * 8);
#if !DBG_NOHS
        acc[jt] = __builtin_amdgcn_mfma_f32_16x16x32_bf16(afr, bfr, acc[jt], 0, 0, 0);
#endif
      }
    }
    float s = 0.f;
#pragma unroll
    for (int jt = 0; jt < 4; ++jt)
#pragma unroll
      for (int e = 0; e < 4; ++e) s += acc[jt][e];
    s += __shfl_xor(s, 16); s += __shfl_xor(s, 32);
    const float mu = s * (1.f / 64.f);
    float vs = 0.f;
#pragma unroll
    for (int jt = 0; jt < 4; ++jt)
#pragma unroll
      for (int e = 0; e < 4; ++e) { const float d = acc[jt][e] - mu; vs += d * d; }
    vs += __shfl_xor(vs, 16); vs += __shfl_xor(vs, 32);
    const float rstd = __builtin_amdgcn_rsqf(vs * (1.f / 64.f) + 64e-5f);
    const size_t tok = (size_t)b * SEQ + c * 64 + tl;
#pragma unroll
    for (int jt = 0; jt < 4; ++jt) {
      const int v = jt * 16 + 4 * g, cc = hd * 64 + v;
      const f32x4 gg = *(const f32x4*)(p.gn_gain + cc), gb = *(const f32x4*)(p.gn_bias + cc);
      const u32x2 bvw = *(const u32x2*)(p.BV + (size_t)item * 4096 + tl * 64 + v);
      const u32x2 gw = *(const u32x2*)(p.GB + tok * 512 + cc);
      float o[4];
      const float bvf[4] = {bflo(bvw.x), bfhi(bvw.x), bflo(bvw.y), bfhi(bvw.y)};
      const float gf[4] = {bflo(gw.x), bfhi(gw.x), bflo(gw.y), bfhi(gw.y)};
#pragma unroll
      for (int e = 0; e < 4; ++e) {
#if DBG_P4 == 1
        o[e] = bvf[e] * gf[e];
#elif DBG_P4 == 2
        o[e] = ((acc[jt][e] - mu) * rstd * gg[e] + gb[e]) * gf[e];
#else
        o[e] = ((acc[jt][e] - mu) * rstd * gg[e] + gb[e] + bvf[e]) * gf[e];
#endif
      }
      u32x2 w; w.x = pk2(o[0], o[1]); w.y = pk2(o[2], o[3]);
      *(u32x2*)(p.Ymix + tok * 1024 + 512 + cc) = w;
    }
  }
}


#define XB_TMO      128
#define XB_XCNT(j)  (256  + 64 * (j))
#define XB_XSUB(j)  (1280 + 64 * (j))
#define XB_XGEN(j)  (2304 + 64 * (j))
#define XB_TOP      3328
#define XB_TOPGEN   3392
#define XCD_BAR_WORDS 3456
#define XB_SPIN_CAP (1u << 18)
#define LAS __attribute__((address_space(3)))
__device__ __forceinline__ unsigned xb_ld(unsigned* p)              { return __hip_atomic_load(p, __ATOMIC_RELAXED, __HIP_MEMORY_SCOPE_AGENT); }
__device__ __forceinline__ unsigned xb_add(unsigned* p, unsigned v) { return __hip_atomic_fetch_add(p, v, __ATOMIC_RELAXED, __HIP_MEMORY_SCOPE_AGENT); }
__device__ __forceinline__ unsigned xb_xcc_id() { return (unsigned)__builtin_amdgcn_s_getreg((3 << 11) | 20) & 0xFu; }
#define XB_SPIN(cond, bar) do { unsigned _sp = 0; while (cond) { __builtin_amdgcn_s_sleep(1); \
    if ((++_sp & 255u) == 0u) { if (xb_ld(&(bar)[XB_TMO])) break; if (_sp > XB_SPIN_CAP) { atomicAdd(&(bar)[XB_TMO], 1u); break; } } } } while (0)
struct XcdBarrier { unsigned* bar; unsigned x; volatile LAS unsigned* st; };
__device__ __forceinline__ XcdBarrier xcd_barrier_post(unsigned* bar, volatile LAS unsigned* st) {
    XcdBarrier b; b.bar = bar; b.x = xb_xcc_id(); b.st = st;
    if (threadIdx.x == 0) (void)xb_add(&bar[XB_XCNT(b.x)], 1u);
    return b;
}
__device__ __forceinline__ void xcd_barrier_complete(unsigned* bar, unsigned x, unsigned& nloc, unsigned& nx) {
    const unsigned G = gridDim.x * gridDim.y * gridDim.z;
    unsigned sum, cnt, mine, sp = 0u;
    for (;;) {
        sum = 0u; cnt = 0u; mine = 0u;
#pragma unroll
        for (unsigned j = 0; j < 16; ++j) { const unsigned c = xb_ld(&bar[XB_XCNT(j)]); sum += c; cnt += (c > 0u) ? 1u : 0u; mine = (j == x) ? c : mine; }
        if (sum == G) break;
        __builtin_amdgcn_s_sleep(1);
        if ((++sp & 255u) == 0u) { if (xb_ld(&bar[XB_TMO])) break; if (sp > XB_SPIN_CAP) { atomicAdd(&bar[XB_TMO], 1u); break; } }
    }
    nloc = mine > 0u ? mine : 1u; nx = cnt > 0u ? cnt : 1u;
}
__device__ __forceinline__ void xcd_barrier(const XcdBarrier& b) {
    asm volatile("s_waitcnt vmcnt(0)" ::: "memory");
    __syncthreads();
    if (threadIdx.x == 0) {
        unsigned* bar = b.bar;
        __builtin_amdgcn_s_waitcnt(0);
        unsigned nloc = b.st[0], nx = b.st[1];
        if (nloc == 0u) { xcd_barrier_complete(bar, b.x, nloc, nx); b.st[0] = nloc; b.st[1] = nx; }
        const unsigned old = xb_add(&bar[XB_XSUB(b.x)], 1u);
        const unsigned gen = old / nloc;
        if (old + 1u == (gen + 1u) * nloc) {
            __builtin_amdgcn_fence(__ATOMIC_RELEASE, "agent");
            asm volatile("s_waitcnt vmcnt(0)" ::: "memory");
            const unsigned og = xb_add(&bar[XB_TOP], 1u);
            const unsigned tg = og / nx;
            if (og + 1u == (tg + 1u) * nx) xb_add(&bar[XB_TOPGEN], 1u);
            else XB_SPIN(xb_ld(&bar[XB_TOPGEN]) == tg, bar);
            __builtin_amdgcn_fence(__ATOMIC_ACQUIRE, "agent");
            xb_add(&bar[XB_XGEN(b.x)], 1u);
            asm volatile("s_waitcnt vmcnt(0)" ::: "memory");
        } else {
            XB_SPIN(xb_ld(&bar[XB_XGEN(b.x)]) == gen, bar);
            __builtin_amdgcn_fence(__ATOMIC_ACQUIRE, "agent");
            asm volatile("s_waitcnt vmcnt(0)" ::: "memory");
        }
    }
    __syncthreads();
}

extern __shared__ __attribute__((aligned(16))) char dyn_lds[];

__global__ void __launch_bounds__(NT) fwd_mega(Params p) {
  cg::grid_group grid = cg::this_grid();
  const int bid = blockIdx.x, nb = gridDim.x;
  volatile LAS unsigned* xst = (volatile LAS unsigned*)(dyn_lds + LDS_BYTES - 32);
  if (threadIdx.x == 0) { xst[0] = 0u; xst[1] = 0u; }
  __syncthreads();
  const XcdBarrier xb = xcd_barrier_post(p.xbar, xst);
  phase_prep(p, dyn_lds, bid, nb);
  xcd_barrier(xb);
#if REP == 7 || REP == 8
  phase_gemm1(p, dyn_lds, bid, nb, REP - 6);
  xcd_barrier(xb);
#endif
  phase_gemm1(p, dyn_lds, bid, nb);
#if REP == 1
  xcd_barrier(xb);
  phase_gemm1(p, dyn_lds, bid, nb);
#endif
  xcd_barrier(xb);
  phase_mix(p, dyn_lds, bid, nb);
#if REP == 3
  __syncthreads();
  phase_prep_only(p, dyn_lds, bid, nb);
#endif
  xcd_barrier(xb);
  phase_scan(p, bid, nb);
#if REP == 10
  xcd_barrier(xb);
#endif
#if REP == 9
  phase_scan(p, bid, nb);
  phase_scan(p, bid, nb);
  phase_scan(p, bid, nb);
  phase_scan(p, bid, nb);
#endif
  phase_attn_queue(p, dyn_lds, bid, nb);
  xcd_barrier(xb);
  phase_rwkv_out(p, bid, nb);
  xcd_barrier(xb);
  const bool fused = (nb & 31) == 0;
  phase_gemm2(p, dyn_lds, bid, nb, fused);
  if (!fused) {
    grid.sync();
    phase_final(p, bid, nb);
  }
}

#if N_LAUNCH_SPLIT
__global__ void __launch_bounds__(NT) k_prep(Params p) { phase_prep(p, dyn_lds, blockIdx.x, gridDim.x); }
__global__ void __launch_bounds__(NT) k_gemm1(Params p) { phase_gemm1(p, dyn_lds, blockIdx.x, gridDim.x); }
__global__ void __launch_bounds__(NT) k_mix(Params p) { phase_mix(p, dyn_lds, blockIdx.x, gridDim.x); }
__global__ void __launch_bounds__(NT) k_scan(Params p) { phase_scan(p, blockIdx.x, gridDim.x); phase_attn_queue(p, dyn_lds, blockIdx.x, gridDim.x); }
__global__ void __launch_bounds__(NT) k_rout(Params p) { phase_rwkv_out(p, blockIdx.x, gridDim.x); }
__global__ void __launch_bounds__(NT) k_gemm2(Params p) { phase_gemm2(p, dyn_lds, blockIdx.x, gridDim.x, false); }
__global__ void __launch_bounds__(NT) k_final(Params p) { phase_final(p, blockIdx.x, gridDim.x); }
#endif

extern "C" void kernel_launch(void* const* d_in, const int* in_sizes, int n_in, void* d_out, int out_size, void* d_ws, size_t ws_size, hipStream_t stream) {
  Params p{};
  p.x = (const float*)d_in[0]; p.norm_gain = (const float*)d_in[1]; p.w_in = (const float*)d_in[2]; p.shift_mu = (const float*)d_in[3];
  p.decay_bias = (const float*)d_in[4]; p.decay_up = (const float*)d_in[5]; p.iclr_bias = (const float*)d_in[6]; p.iclr_up = (const float*)d_in[7];
  p.k_k = (const float*)d_in[8]; p.k_a = (const float*)d_in[9]; p.r_k = (const float*)d_in[10]; p.gn_gain = (const float*)d_in[11]; p.gn_bias = (const float*)d_in[12];
  p.w_out = (const float*)d_in[13]; p.final_gain = (const float*)d_in[14];
  p.out = (float*)d_out;
  char* w = (char*)d_ws; size_t off = 0;
  auto take = [&](size_t bytes) { char* r = w + off; off += (bytes + 255) & ~(size_t)255; return r; };
  char* r1 = take((size_t)TOK * DM * 2);
  p.xb = (u16*)r1; p.Pm = (u16*)r1; p.Ry = (u16*)(r1 + (size_t)4096 * 4096 * 2);
  p.winT = (u16*)take((size_t)INW * DM * 2);
  p.woutT = (u16*)take((size_t)DM * DM * 2);
  p.Q = (u16*)take((size_t)TOK * 512 * 2);
  p.K = (u16*)take((size_t)TOK * 512 * 2);
  p.Vt = (u16*)take((size_t)TOK * 512 * 2);
  p.GA = (u16*)take((size_t)TOK * 512 * 2);
  p.GB = (u16*)take((size_t)TOK * 512 * 2);
  p.PB = (u16*)take((size_t)TOK * PBW * 2); p.Hs = p.PB;
  p.Ymix = (u16*)take((size_t)TOK * DM * 2);
  p.BV = (u16*)take((size_t)TOK * 512 * 2);
  p.DUt = (u16*)take(512 * 64 * 2); p.IUt = (u16*)take(512 * 64 * 2);
  p.rs = (float*)take((size_t)TOK * 4); p.ssq = (float*)take((size_t)TOK * 4);
  p.ctab = (float*)take((size_t)SEQ * 32 * 4); p.stab = (float*)take((size_t)SEQ * 32 * 4);
  p.kmean = (float*)take((size_t)64 * 16 * 64 * 4);
  p.qctr = (int*)take(256);
  p.pcnt = (int*)take(128 * 4);
  p.xbar = (unsigned*)take(XCD_BAR_WORDS * 4);
  p.QT = (u16*)d_out; p.Y0 = (u16*)d_out + (size_t)4096 * 4096;

  static int grid_blocks = 0;
  if (!grid_blocks) {
    int dev = 0, cus = 0, per_cu = 0;
    hipGetDevice(&dev);
    hipDeviceGetAttribute(&cus, hipDeviceAttributeMultiprocessorCount, dev);
    hipFuncSetAttribute((const void*)fwd_mega, hipFuncAttributeMaxDynamicSharedMemorySize, LDS_BYTES);
    hipOccupancyMaxActiveBlocksPerMultiprocessor(&per_cu, fwd_mega, NT, LDS_BYTES);
    if (per_cu < 1) per_cu = 1;
    if (per_cu > 1) per_cu = 1;
    grid_blocks = cus * per_cu;
#if N_LAUNCH_SPLIT
    hipFuncSetAttribute((const void*)k_prep, hipFuncAttributeMaxDynamicSharedMemorySize, LDS_BYTES);
    hipFuncSetAttribute((const void*)k_gemm1, hipFuncAttributeMaxDynamicSharedMemorySize, LDS_BYTES);
    hipFuncSetAttribute((const void*)k_mix, hipFuncAttributeMaxDynamicSharedMemorySize, LDS_BYTES);
    hipFuncSetAttribute((const void*)k_gemm2, hipFuncAttributeMaxDynamicSharedMemorySize, LDS_BYTES);
    hipFuncSetAttribute((const void*)k_scan, hipFuncAttributeMaxDynamicSharedMemorySize, LDS_BYTES);
#endif
  }
#if N_LAUNCH_SPLIT
  const int G = grid_blocks;
  k_prep<<<G, NT, LDS_BYTES, stream>>>(p);
#if DBG_STAGE < 3
  hipMemsetAsync(p.Ymix, 0, (size_t)TOK * DM * 2, stream);
#endif
#if DBG_STAGE >= 1
  k_gemm1<<<G, NT, LDS_BYTES, stream>>>(p);
#endif
#if DBG_STAGE >= 2
  k_mix<<<G, NT, LDS_BYTES, stream>>>(p);
#endif
#if DBG_STAGE >= 3
  k_scan<<<G, NT, LDS_BYTES, stream>>>(p);
  k_rout<<<G, NT, 0, stream>>>(p);
#endif
  k_gemm2<<<G, NT, LDS_BYTES, stream>>>(p);
  k_final<<<G, NT, 0, stream>>>(p);
#else
  (void)hipMemsetAsync(p.xbar, 0, XCD_BAR_WORDS * 4, stream);
  void* args[] = {&p};
  hipError_t e = hipLaunchCooperativeKernel((const void*)fwd_mega, dim3(grid_blocks), dim3(NT), args, LDS_BYTES, stream);
  if (e != hipSuccess) fprintf(stderr, "cooperative launch failed: %s (grid %d)\n", hipGetErrorString(e), grid_blocks);
#endif
}
```

```cpp
#include <hip/hip_runtime.h>
#include <hip/hip_cooperative_groups.h>
#include <cstdio>
#include <cstdint>
#include <type_traits>
namespace cg = cooperative_groups;

#ifndef DBG_STAGE
#define DBG_STAGE 3
#endif
#ifndef ATTN_SGB
#define ATTN_SGB 0
#endif
#ifndef REP
#define REP 0
#endif
#ifndef N_LAUNCH_SPLIT
#define N_LAUNCH_SPLIT 0
#endif

typedef unsigned short u16;
typedef short bf16x8 __attribute__((ext_vector_type(8)));
typedef float f32x4 __attribute__((ext_vector_type(4)));
typedef float f32x16 __attribute__((ext_vector_type(16)));
typedef unsigned u32x2 __attribute__((ext_vector_type(2)));
typedef unsigned u32x4 __attribute__((ext_vector_type(4)));

constexpr int NT = 512;
constexpr int DM = 1024, BATCH = 8, SEQ = 4096, TOK = BATCH * SEQ;
constexpr int INW = 4224, PBW = 1664;
constexpr int LDS_BYTES = 148 * 1024;
constexpr int LD = 72;

struct Params {
  const float *x, *norm_gain, *w_in, *shift_mu, *decay_bias, *decay_up, *iclr_bias, *iclr_up, *k_k, *k_a, *r_k, *gn_gain, *gn_bias, *w_out, *final_gain;
  float* out;
  u16 *xb, *winT, *woutT, *Q, *K, *Vt, *GA, *PB, *GB, *Ymix, *DUt, *IUt, *Pm, *Ry, *BV, *Hs;
  float *rs, *ctab, *stab, *kmean, *ssq;
  u16 *QT, *Y0;
  int* qctr;
  int* pcnt;
  unsigned* xbar;
};

typedef __bf16 bf16x2_t __attribute__((ext_vector_type(2)));
typedef float f32x2_t __attribute__((ext_vector_type(2)));
__device__ __forceinline__ unsigned pk2(float lo, float hi) { f32x2_t v = {lo, hi}; bf16x2_t b = __builtin_convertvector(v, bf16x2_t); return __builtin_bit_cast(unsigned, b); }
__device__ __forceinline__ float bf2f(unsigned v) { return __uint_as_float(v << 16); }
__device__ __forceinline__ float bflo(unsigned v) { return __uint_as_float(v << 16); }
__device__ __forceinline__ float bfhi(unsigned v) { return __uint_as_float(v & 0xffff0000u); }
__device__ __forceinline__ int rm32(int reg, int h) { return (reg & 3) + 8 * (reg >> 2) + 4 * h; }
__device__ __forceinline__ float fexp(float x) { return __builtin_amdgcn_exp2f(x * 1.44269504088896f); }
__device__ __forceinline__ float fsigmoid(float x) { return __builtin_amdgcn_rcpf(1.f + fexp(-x)); }

__device__ void transpose_bf16(const float* __restrict__ src, int Kr, int Nc, u16* __restrict__ dst, const float* __restrict__ rowscale, char* lds, int bid, int nb) {
  float* ts = (float*)lds;
  const int tid = threadIdx.x;
  const int tk = Kr / 64, tn = Nc / 64;
  for (int t = bid; t < tk * tn; t += nb) {
    const int k0 = (t / tn) * 64, c0 = (t % tn) * 64;
#pragma unroll
    for (int i = 0; i < 2; ++i) {
      const int r = (tid >> 4) + 32 * i, c4 = (tid & 15) * 4;
      f32x4 v = *(const f32x4*)(src + (size_t)(k0 + r) * Nc + c0 + c4);
      const float sc = rowscale ? rowscale[k0 + r] : 1.f;
#pragma unroll
      for (int e = 0; e < 4; ++e) ts[(c4 + e) * 65 + r] = v[e] * sc;
    }
    __syncthreads();
    {
      const int c = tid >> 3, ch = tid & 7;
      const float* tp = ts + c * 65 + ch * 8;
      u32x4 w; w.x = pk2(tp[0], tp[1]); w.y = pk2(tp[2], tp[3]); w.z = pk2(tp[4], tp[5]); w.w = pk2(tp[6], tp[7]);
      *(u32x4*)(dst + (size_t)(c0 + c) * Kr + k0 + ch * 8) = w;
    }
    __syncthreads();
  }
}

__device__ void phase_prep(const Params& p, char* lds, int bid, int nb) {
  const int tid = threadIdx.x, lane = tid & 63, wave = tid >> 6;
  for (int row = bid * 8 + wave; row < TOK; row += nb * 8) {
    const float* xr = p.x + (size_t)row * DM;
    float ss = 0.f;
#pragma unroll
    for (int i = 0; i < 4; ++i) {
      f32x4 v = __builtin_nontemporal_load((const f32x4*)(xr + i * 256 + lane * 4));
      ss += v[0] * v[0] + v[1] * v[1] + v[2] * v[2] + v[3] * v[3];
      u32x2 w; w.x = pk2(v[0], v[1]); w.y = pk2(v[2], v[3]);
      *(u32x2*)(p.xb + (size_t)row * DM + i * 256 + lane * 4) = w;
    }
#pragma unroll
    for (int o = 32; o >= 1; o >>= 1) ss += __shfl_xor(ss, o);
    if (lane == 0) p.rs[row] = __builtin_amdgcn_rsqf(ss * (1.f / DM) + 1e-6f);
  }
  transpose_bf16(p.w_in, DM, INW, p.winT, p.norm_gain, lds, bid, nb);
  transpose_bf16(p.w_out, DM, DM, p.woutT, nullptr, lds, bid, nb);
  const int gt = bid * NT + tid, gn = nb * NT;
  for (int i = gt; i < 512 * 64; i += gn) {
    const int c = i >> 6, j = i & 63;
    p.DUt[i] = (u16)pk2(p.decay_up[j * 512 + c], 0.f);
    p.IUt[i] = (u16)pk2(p.iclr_up[j * 512 + c], 0.f);
  }
  for (int i = gt; i < SEQ * 32; i += gn) {
    const int t = i >> 5, f = i & 31;
    const float invf = __builtin_amdgcn_exp2f(-(float)f * (13.287712379549449f / 32.f));
    const float ang = (float)t * invf;
    double rev = (double)ang * 0.15915494309189535;
    rev -= __builtin_rint(rev);
    const float fr = (float)rev;
    p.ctab[i] = __builtin_amdgcn_cosf(fr);
    p.stab[i] = __builtin_amdgcn_sinf(fr);
  }
  for (int i = gt; i < TOK; i += gn) p.ssq[i] = 0.f;
  if (gt < 64) p.qctr[gt] = 0;
  if (gt < 128) p.pcnt[gt] = 0;
}

template <class Epi>
__device__ __forceinline__ void gemm_tile(const u16* __restrict__ A, const u16* __restrict__ Bt, int K, int m0, int n0, int nmax, char* lds, Epi&& epi, int nk_override = 0, bool partial = false) {
  int tid = threadIdx.x;
  asm volatile("" : "+v"(tid));
  const int lane = tid & 63, wave = __builtin_amdgcn_readfirstlane(tid >> 6), l31 = lane & 31, h = lane >> 5;
  const int wr = partial ? ((wave & 3) >> 1) : (wave >> 2);
  const int wc = partial ? ((wave & 1) + 2 * (wave >> 2)) : (wave & 3);
  const bool domma = !partial || wave < 4;
  u16* As0 = (u16*)lds;
  u16* Bs0 = As0 + 2 * 256 * LD;
  f32x16 acc[2][4];
#pragma unroll
  for (int a = 0; a < 2; ++a)
#pragma unroll
    for (int b = 0; b < 4; ++b)
#pragma unroll
      for (int r = 0; r < 16; ++r) acc[a][b][r] = 0.f;
  u32x4 ra[4], rb[4];
  const int srow = tid >> 3, skc = tid & 7;
  const u16* Ag = A + (size_t)(m0 + srow) * K + skc * 8;
  const u16* Bg[4];
#pragma unroll
  for (int i = 0; i < 4; ++i) { int n = n0 + srow + 64 * i; n = n < nmax ? n : nmax - 1; Bg[i] = Bt + (size_t)n * K + skc * 8; }
  const int nk = nk_override ? nk_override : K / 64;
#pragma unroll
  for (int i = 0; i < 4; ++i) { ra[i] = *(const u32x4*)(Ag + (size_t)(64 * i) * K); rb[i] = *(const u32x4*)(Bg[i]); }
#pragma unroll
  for (int i = 0; i < 4; ++i) { *(u32x4*)(As0 + (srow + 64 * i) * LD + skc * 8) = ra[i]; *(u32x4*)(Bs0 + (srow + 64 * i) * LD + skc * 8) = rb[i]; }
  if (nk > 1) {
#pragma unroll
    for (int i = 0; i < 4; ++i) { ra[i] = *(const u32x4*)(Ag + (size_t)(64 * i) * K + 64); rb[i] = *(const u32x4*)(Bg[i] + 64); }
  }
  for (int kt = 0; kt < nk; ++kt) {
    __syncthreads();
    if (kt + 1 < nk) {
      u16* aw = As0 + ((kt + 1) & 1) * 256 * LD;
      u16* bw = Bs0 + ((kt + 1) & 1) * 256 * LD;
#pragma unroll
      for (int i = 0; i < 4; ++i) { *(u32x4*)(aw + (srow + 64 * i) * LD + skc * 8) = ra[i]; *(u32x4*)(bw + (srow + 64 * i) * LD + skc * 8) = rb[i]; }
    }
    if (kt + 2 < nk) {
#pragma unroll
      for (int i = 0; i < 4; ++i) { ra[i] = *(const u32x4*)(Ag + (size_t)(64 * i) * K + (kt + 2) * 64); rb[i] = *(const u32x4*)(Bg[i] + (kt + 2) * 64); }
    }
    __builtin_amdgcn_sched_barrier(0);
    const u16* as = As0 + (kt & 1) * 256 * LD + (wr * 128 + l31) * LD + h * 8;
    const u16* bs = Bs0 + (kt & 1) * 256 * LD + (wc * 64 + l31) * LD + h * 8;
    if (domma)
#pragma unroll
    for (int ks = 0; ks < 4; ++ks) {
      bf16x8 wf[2], xf[4];
#pragma unroll
      for (int ct = 0; ct < 2; ++ct) wf[ct] = *(const bf16x8*)(bs + ct * 32 * LD + ks * 16);
#pragma unroll
      for (int tt = 0; tt < 4; ++tt) xf[tt] = *(const bf16x8*)(as + tt * 32 * LD + ks * 16);
#pragma unroll
      for (int ct = 0; ct < 2; ++ct)
#pragma unroll
        for (int tt = 0; tt < 4; ++tt) acc[ct][tt] = __builtin_amdgcn_mfma_f32_32x32x16_bf16(wf[ct], xf[tt], acc[ct][tt], 0, 0, 0);
    }
    __builtin_amdgcn_sched_barrier(0);
  }
  __syncthreads();
  epi(acc, m0, n0, wr, wc, l31, h);
}

__device__ void phase_gemm1(const Params& p, char* lds, int bid, int nb, int mode = 0) {
  const int tid = threadIdx.x;
  constexpr int NMT = TOK / 256, NNT = (INW + 255) / 256;
  const int xcd = bid & 7, jx = bid >> 3, nbx = (nb + 7 - xcd) >> 3;
  for (int Lx = jx; Lx < (NMT / 8) * NNT; Lx += nbx) {
    const int grp = Lx / (2 * NNT), gi = Lx % (2 * NNT);
    const int mt = xcd * (NMT / 8) + 2 * grp + (gi & 1), nt = gi >> 1;
    gemm_tile(p.xb, p.winT, DM, mt * 256, nt * 256, INW, lds, [&](f32x16 (&acc)[2][4], int m0, int n0, int wr, int wc, int l31, int h) {
      float rsv[4]; int tok[4];
#pragma unroll
      for (int tt = 0; tt < 4; ++tt) { tok[tt] = m0 + wr * 128 + tt * 32 + l31; rsv[tt] = p.rs[tok[tt]]; }
      if (mode == 1) {
        float sacc = 0.f;
#pragma unroll
        for (int ct = 0; ct < 2; ++ct)
#pragma unroll
          for (int tt = 0; tt < 4; ++tt)
#pragma unroll
            for (int r = 0; r < 16; ++r) sacc += acc[ct][tt][r];
        if (sacc == 123.456f) p.rs[tok[0]] = sacc;
        return;
      }
      const int nw = n0 + wc * 64;
      const int lane = h * 32 + l31;
      u16* stg = (u16*)lds + (wr * 4 + wc) * (128 * LD);
      float* red = (float*)(lds + 8 * 128 * LD * 2);
      const int bq = m0 >> 12, pos0 = (m0 & 4095) + wr * 128;
      auto flush_rows = [&](u16* gbase, size_t ldd) {
#pragma unroll
        for (int it = 0; it < 16; ++it) {
          const int r = it * 8 + (lane >> 3), ch = lane & 7;
          *(u32x4*)(gbase + (size_t)r * ldd + ch * 8) = *(const u32x4*)(stg + r * LD + ch * 8);
        }
      };
      if (n0 < 1024) {
        const bool isq = n0 < 512;
        const int head = (nw & 511) >> 6;
        const float osc = isq ? (0.125f * 1.44269504088896f) : 1.f;
        u16* dst = isq ? p.Q : p.K;
        float ksum[2][16];
#pragma unroll
        for (int ct = 0; ct < 2; ++ct)
#pragma unroll
          for (int r = 0; r < 16; ++r) ksum[ct][r] = 0.f;
#pragma unroll
        for (int tt = 0; tt < 4; ++tt) {
          __builtin_amdgcn_sched_barrier(0);
          const int pos = tok[tt] & 4095;
          u16* srow = stg + (tt * 32 + l31) * LD;
#pragma unroll
          for (int rq = 0; rq < 4; ++rq) {
            const int i0 = 8 * rq + 4 * h;
            const f32x4 c4 = *(const f32x4*)(p.ctab + pos * 32 + i0);
            const f32x4 s4 = *(const f32x4*)(p.stab + pos * 32 + i0);
            float y1[4], y2[4];
#pragma unroll
            for (int e = 0; e < 4; ++e) {
              const float x1 = acc[0][tt][rq * 4 + e] * rsv[tt], x2 = acc[1][tt][rq * 4 + e] * rsv[tt];
              y1[e] = (x1 * c4[e] - x2 * s4[e]) * osc;
              y2[e] = (x2 * c4[e] + x1 * s4[e]) * osc;
              ksum[0][rq * 4 + e] += y1[e];
              ksum[1][rq * 4 + e] += y2[e];
            }
            u32x2 w1, w2; w1.x = pk2(y1[0], y1[1]); w1.y = pk2(y1[2], y1[3]); w2.x = pk2(y2[0], y2[1]); w2.y = pk2(y2[2], y2[3]);
            *(u32x2*)(srow + i0) = w1;
            *(u32x2*)(srow + 32 + i0) = w2;
          }
        }
        flush_rows(dst + ((size_t)(bq * 8 + head) * SEQ + pos0) * 64, 64);
        if (!isq) {
#pragma unroll
          for (int ct = 0; ct < 2; ++ct)
#pragma unroll
            for (int r = 0; r < 16; ++r) {
              float v = ksum[ct][r];
              v += __shfl_xor(v, 1); v += __shfl_xor(v, 2); v += __shfl_xor(v, 4); v += __shfl_xor(v, 8); v += __shfl_xor(v, 16);
              if (l31 == 0) red[wr * 256 + wc * 64 + ct * 32 + rm32(r, h)] = v;
            }
        }
        __syncthreads();
        if (!isq && tid < 256) {
          const float sres = red[tid] + red[256 + tid];
          const int blk = (m0 & 4095) >> 8, hd = ((n0 & 511) >> 6) + (tid >> 6);
          p.kmean[((size_t)(bq * 8 + hd) * 16 + blk) * 64 + (tid & 63)] = sres * (1.f / 256.f);
        }
      } else if (nw < 1536) {
        const int head = (nw - 1024) >> 6;
        constexpr int VLD = 136;
#pragma unroll
        for (int tt = 0; tt < 4; ++tt)
#pragma unroll
          for (int ct = 0; ct < 2; ++ct)
#pragma unroll
            for (int r = 0; r < 16; r += 2) {
              const unsigned w = pk2(acc[ct][tt][r] * rsv[tt], acc[ct][tt][r + 1] * rsv[tt]);
              stg[(ct * 32 + rm32(r, h)) * VLD + tt * 32 + l31] = (u16)(w & 0xffffu);
              stg[(ct * 32 + rm32(r + 1, h)) * VLD + tt * 32 + l31] = (u16)(w >> 16);
            }
        u16* gbase = p.Vt + (size_t)(bq * 8 + head) * 64 * SEQ + pos0;
#pragma unroll
        for (int it = 0; it < 16; ++it) {
          const int d = it * 4 + (lane >> 4), ch = lane & 15;
          *(u32x4*)(gbase + (size_t)d * SEQ + ch * 8) = *(const u32x4*)(stg + d * VLD + ch * 8);
        }
      } else if (nw < INW) {
        u16* dst; int ldd, c0; bool act;
        if (nw < 2048) { dst = p.GA; ldd = 512; c0 = nw - 1536; act = true; }
        else if (nw < 3712) { dst = p.PB; ldd = PBW; c0 = nw - 2048; act = false; }
        else { dst = p.GB; ldd = 512; c0 = nw - 3712; act = true; }
#pragma unroll
        for (int tt = 0; tt < 4; ++tt) {
          u16* srow = stg + (tt * 32 + l31) * LD;
#pragma unroll
          for (int ct = 0; ct < 2; ++ct)
#pragma unroll
            for (int rq = 0; rq < 4; ++rq) {
              float v[4];
#pragma unroll
              for (int e = 0; e < 4; ++e) { v[e] = acc[ct][tt][rq * 4 + e] * rsv[tt]; if (act) v[e] = v[e] * fsigmoid(v[e]); }
              u32x2 w; w.x = pk2(v[0], v[1]); w.y = pk2(v[2], v[3]);
              *(u32x2*)(srow + ct * 32 + 8 * rq + 4 * h) = w;
            }
        }
        flush_rows(dst + (size_t)(m0 + wr * 128) * ldd + c0, (size_t)ldd);
      }
      __syncthreads();
    }, mode == 2 ? 1 : 0, nt == NNT - 1);
  }
}

__device__ void phase_gemm2(const Params& p, char* lds, int bid, int nb, bool fused) {
  constexpr int NMT = TOK / 256, NNT = DM / 256;
  const int xcd = bid & 7, jx = bid >> 3, nbx = (nb + 7 - xcd) >> 3;
  for (int Lx = jx; Lx < (NMT / 8) * NNT; Lx += nbx) {
    const int mt = xcd * (NMT / 8) + Lx / NNT, nt = Lx % NNT;
    gemm_tile(p.Ymix, p.woutT, DM, mt * 256, nt * 256, DM, lds, [&](f32x16 (&acc)[2][4], int m0, int n0, int wr, int wc, int l31, int h) {
      float olds[4];
#pragma unroll
      for (int tt = 0; tt < 4; ++tt) {
        const int tok = m0 + wr * 128 + tt * 32 + l31;
        const float* xr = p.x + (size_t)tok * DM + n0 + wc * 64;
        float ss = 0.f;
#pragma unroll
        for (int ct = 0; ct < 2; ++ct)
#pragma unroll
          for (int rq = 0; rq < 4; ++rq) {
            const f32x4 xv = *(const f32x4*)(xr + ct * 32 + 8 * rq + 4 * h);
#pragma unroll
            for (int e = 0; e < 4; ++e) { acc[ct][tt][rq * 4 + e] += xv[e]; ss += acc[ct][tt][rq * 4 + e] * acc[ct][tt][rq * 4 + e]; }
          }
        ss += __shfl_xor(ss, 32);
        olds[tt] = 0.f;
        if (h == 0) olds[tt] = atomicAdd(p.ssq + tok, ss);
      }
      asm volatile("" :: "v"(olds[0]), "v"(olds[1]), "v"(olds[2]), "v"(olds[3]));
      if (fused) {
        __syncthreads();
        if (threadIdx.x == 0) {
          __hip_atomic_fetch_add(p.pcnt + (m0 >> 8), 1, __ATOMIC_RELAXED, __HIP_MEMORY_SCOPE_AGENT);
          while (__hip_atomic_load(p.pcnt + (m0 >> 8), __ATOMIC_RELAXED, __HIP_MEMORY_SCOPE_AGENT) < NNT) __builtin_amdgcn_s_sleep(2);
        }
        __syncthreads();
      }
#pragma unroll
      for (int tt = 0; tt < 4; ++tt) {
        const int tok = m0 + wr * 128 + tt * 32 + l31;
        float sc = 1.f;
        if (fused) sc = __builtin_amdgcn_rsqf(__hip_atomic_load(p.ssq + tok, __ATOMIC_RELAXED, __HIP_MEMORY_SCOPE_AGENT) * (1.f / DM) + 1e-6f);
        float* orow = p.out + (size_t)tok * DM + n0 + wc * 64;
        const float* gr = p.final_gain + n0 + wc * 64;
#pragma unroll
        for (int ct = 0; ct < 2; ++ct)
#pragma unroll
          for (int rq = 0; rq < 4; ++rq) {
            const int c = ct * 32 + 8 * rq + 4 * h;
            f32x4 o;
            if (fused) {
              const f32x4 gv = *(const f32x4*)(gr + c);
#pragma unroll
              for (int e = 0; e < 4; ++e) o[e] = acc[ct][tt][rq * 4 + e] * sc * gv[e];
            } else {
#pragma unroll
              for (int e = 0; e < 4; ++e) o[e] = acc[ct][tt][rq * 4 + e];
            }
            *(f32x4*)(orow + c) = o;
          }
      }
    });
  }
}

__device__ void phase_final(const Params& p, int bid, int nb) {
  const int gt = bid * NT + threadIdx.x, gn = nb * NT;
  for (int i = gt; i < TOK * (DM / 4); i += gn) {
    const int row = i >> 8, c = (i & 255) * 4;
    const float sc = __builtin_amdgcn_rsqf(p.ssq[row] * (1.f / DM) + 1e-6f);
    f32x4 v = *(f32x4*)(p.out + (size_t)row * DM + c);
    const f32x4 g = *(const f32x4*)(p.final_gain + c);
#pragma unroll
    for (int e = 0; e < 4; ++e) v[e] = v[e] * sc * g[e];
    *(f32x4*)(p.out + (size_t)row * DM + c) = v;
  }
}

__device__ void attn_item(const Params& p, char* lds, int bh, int qi) {
  const int tid = threadIdx.x, lane = tid & 63, wave = tid >> 6, l31 = lane & 31, h = lane >> 5;
  u16* Ks = (u16*)lds;
  u16* Vs = Ks + 2 * 64 * LD;
  float* km = (float*)(Vs + 2 * 64 * LD);
  const u16* Qg = p.Q + (size_t)bh * SEQ * 64;
  const u16* Kg = p.K + (size_t)bh * SEQ * 64;
  const u16* Vg = p.Vt + (size_t)bh * 64 * SEQ;
  __syncthreads();
  for (int i = tid; i < 16 * 64; i += NT) km[i] = p.kmean[(size_t)bh * 16 * 64 + i];
  const int qpos = qi * 256 + wave * 32 + l31;
  bf16x8 qf[4];
#pragma unroll
  for (int ks = 0; ks < 4; ++ks) qf[ks] = *(const bf16x8*)(Qg + (size_t)qpos * 64 + ks * 16 + 8 * h);
  __syncthreads();
  unsigned selmask = 0;
  if (qi <= 3) selmask = (1u << qi) - 1u;
  else {
    float v0 = -INFINITY, v1 = -INFINITY, v2 = -INFINITY; int i0 = 0, i1 = 0, i2 = 0;
    for (int j = 0; j < qi; ++j) {
      float g = 0.f;
#pragma unroll
      for (int ks = 0; ks < 4; ++ks) {
        const f32x4 ka = *(const f32x4*)(km + j * 64 + ks * 16 + 8 * h);
        const f32x4 kb = *(const f32x4*)(km + j * 64 + ks * 16 + 8 * h + 4);
#pragma unroll
        for (int e = 0; e < 4; ++e) {
          g += bf2f((unsigned)(u16)qf[ks][e]) * ka[e];
          g += bf2f((unsigned)(u16)qf[ks][4 + e]) * kb[e];
        }
      }
      g += __shfl_xor(g, 32);
      if (g > v0) { v2 = v1; i2 = i1; v1 = v0; i1 = i0; v0 = g; i0 = j; }
      else if (g > v1) { v2 = v1; i2 = i1; v1 = g; i1 = j; }
      else if (g > v2) { v2 = g; i2 = j; }
    }
    selmask = (1u << i0) | (1u << i1) | (1u << i2);
  }
  f32x16 O[2];
#pragma unroll
  for (int d = 0; d < 2; ++d)
#pragma unroll
    for (int r = 0; r < 16; ++r) O[d][r] = 0.f;
  float mref = 0.f, lsum = 0.f;
  bool first = true;
  const int nsteps = (qi + 1) * 4;
  const int skey = tid >> 3, sch = tid & 7;
  u32x4 rk, rv;
  auto gload = [&](int s) {
    const int jb = qi - (s >> 2), sub = s & 3, key0 = jb * 256 + sub * 64;
    rk = *(const u32x4*)(Kg + (size_t)(key0 + skey) * 64 + sch * 8);
    rv = *(const u32x4*)(Vg + (size_t)skey * SEQ + key0 + sch * 8);
  };
  auto swrite = [&](int buf) {
    *(u32x4*)(Ks + buf * 64 * LD + skey * LD + sch * 8) = rk;
    u16* vd = Vs + buf * 64 * LD + skey * LD + 16 * (sch >> 1) + 4 * (sch & 1);
    u32x2 a, b; a.x = rv.x; a.y = rv.y; b.x = rv.z; b.y = rv.w;
    *(u32x2*)(vd) = a;
    *(u32x2*)(vd + 8) = b;
  };
  gload(0); swrite(0);
  __syncthreads();
  auto fast_step = [&](auto diag_, int s, int sub, bool sel) {
    constexpr bool DIAG = decltype(diag_)::value;
    const u16* ks_ = Ks + (s & 1) * 64 * LD + l31 * LD + 8 * h;
    const u16* vs_ = Vs + (s & 1) * 64 * LD + l31 * LD + 8 * h;
    f32x16 cb, S0, S1;
    {
      const float cinit = sel ? -mref : -INFINITY;
#pragma unroll
      for (int r = 0; r < 16; ++r) cb[r] = cinit;
    }
    S0 = __builtin_amdgcn_mfma_f32_32x32x16_bf16(*(const bf16x8*)(ks_), qf[0], cb, 0, 0, 0);
#pragma unroll
    for (int ks = 1; ks < 4; ++ks) S0 = __builtin_amdgcn_mfma_f32_32x32x16_bf16(*(const bf16x8*)(ks_ + ks * 16), qf[ks], S0, 0, 0, 0);
    S1 = __builtin_amdgcn_mfma_f32_32x32x16_bf16(*(const bf16x8*)(ks_ + 32 * LD), qf[0], cb, 0, 0, 0);
#pragma unroll
    for (int ks = 1; ks < 4; ++ks) S1 = __builtin_amdgcn_mfma_f32_32x32x16_bf16(*(const bf16x8*)(ks_ + 32 * LD + ks * 16), qf[ks], S1, 0, 0, 0);
    if constexpr (DIAG) {
      const int qrel = wave * 32 + l31;
#pragma unroll
      for (int r = 0; r < 16; ++r) {
        const int krel = sub * 64 + rm32(r, h);
        S0[r] = (krel <= qrel) ? S0[r] : -INFINITY;
        S1[r] = (krel + 32 <= qrel) ? S1[r] : -INFINITY;
      }
    }
    float mx0 = -INFINITY, mx1 = -INFINITY, ps0 = 0.f, ps1 = 0.f;
#pragma unroll
    for (int r = 0; r < 16; r += 2) mx0 = fmaxf(fmaxf(mx0, S0[r]), S0[r + 1]);
#pragma unroll
    for (int r = 0; r < 16; ++r) { S0[r] = __builtin_amdgcn_exp2f(S0[r]); ps0 += S0[r]; }
#pragma unroll
    for (int sp = 0; sp < 2; ++sp) {
      u32x4 pw;
      pw.x = pk2(S0[8 * sp + 0], S0[8 * sp + 1]); pw.y = pk2(S0[8 * sp + 2], S0[8 * sp + 3]);
      pw.z = pk2(S0[8 * sp + 4], S0[8 * sp + 5]); pw.w = pk2(S0[8 * sp + 6], S0[8 * sp + 7]);
      const bf16x8 pb = __builtin_bit_cast(bf16x8, pw);
#pragma unroll
      for (int d = 0; d < 2; ++d) O[d] = __builtin_amdgcn_mfma_f32_32x32x16_bf16(*(const bf16x8*)(vs_ + d * 32 * LD + sp * 16), pb, O[d], 0, 0, 0);
    }
#pragma unroll
    for (int r = 0; r < 16; r += 2) mx1 = fmaxf(fmaxf(mx1, S1[r]), S1[r + 1]);
#pragma unroll
    for (int r = 0; r < 16; ++r) { S1[r] = __builtin_amdgcn_exp2f(S1[r]); ps1 += S1[r]; }
#pragma unroll
    for (int sp = 0; sp < 2; ++sp) {
      u32x4 pw;
      pw.x = pk2(S1[8 * sp + 0], S1[8 * sp + 1]); pw.y = pk2(S1[8 * sp + 2], S1[8 * sp + 3]);
      pw.z = pk2(S1[8 * sp + 4], S1[8 * sp + 5]); pw.w = pk2(S1[8 * sp + 6], S1[8 * sp + 7]);
      const bf16x8 pb = __builtin_bit_cast(bf16x8, pw);
#pragma unroll
      for (int d = 0; d < 2; ++d) O[d] = __builtin_amdgcn_mfma_f32_32x32x16_bf16(*(const bf16x8*)(vs_ + d * 32 * LD + 32 + sp * 16), pb, O[d], 0, 0, 0);
    }
    lsum += ps0 + ps1;
#if ATTN_SGB
    __builtin_amdgcn_sched_group_barrier(0x008, 4, 0);
#pragma unroll
    for (int i = 0; i < 4; ++i) { __builtin_amdgcn_sched_group_barrier(0x008, 1, 0); __builtin_amdgcn_sched_group_barrier(0x002, 12, 0); }
#pragma unroll
    for (int i = 0; i < 4; ++i) { __builtin_amdgcn_sched_group_barrier(0x008, 1, 0); __builtin_amdgcn_sched_group_barrier(0x002, 12, 0); }
    __builtin_amdgcn_sched_group_barrier(0x008, 4, 0);
#endif
    float mx = fmaxf(mx0, mx1);
    mx = fmaxf(mx, __shfl_xor(mx, 32));
    if (__ballot(mx > 8.f) != 0ull) {
      const float delta = (mx > 8.f) ? mx : 0.f;
      const float alpha = __builtin_amdgcn_exp2f(-delta);
      mref += delta;
      lsum *= alpha;
#pragma unroll
      for (int d = 0; d < 2; ++d)
#pragma unroll
        for (int r = 0; r < 16; ++r) O[d][r] *= alpha;
    }
  };
  for (int s = 0; s < nsteps; ++s) {
    if (s + 1 < nsteps) gload(s + 1);
    const int jb = qi - (s >> 2), sub = s & 3;
    const bool own = (s < 4);
    const bool sel = own ? true : ((selmask >> jb) & 1u);
    bool active;
    if (own) active = (sub * 64 <= wave * 32 + 31);
    else active = (__ballot(sel) != 0ull);
    if (active && s > 0) {
      if (own && (sub * 64 + 63 > wave * 32)) fast_step(std::true_type{}, s, sub, sel);
      else fast_step(std::false_type{}, s, sub, sel);
    } else if (active) {
      const u16* ks_ = Ks + (s & 1) * 64 * LD + l31 * LD + 8 * h;
      const u16* vs_ = Vs + (s & 1) * 64 * LD + l31 * LD + 8 * h;
      f32x16 S[2], cb;
      {
        const float cinit = sel ? -mref : -INFINITY;
#pragma unroll
        for (int r = 0; r < 16; ++r) cb[r] = cinit;
      }
#pragma unroll
      for (int kt = 0; kt < 2; ++kt) {
        {
          const bf16x8 kf = *(const bf16x8*)(ks_ + kt * 32 * LD);
          S[kt] = __builtin_amdgcn_mfma_f32_32x32x16_bf16(kf, qf[0], cb, 0, 0, 0);
        }
#pragma unroll
        for (int ks = 1; ks < 4; ++ks) {
          const bf16x8 kf = *(const bf16x8*)(ks_ + kt * 32 * LD + ks * 16);
          S[kt] = __builtin_amdgcn_mfma_f32_32x32x16_bf16(kf, qf[ks], S[kt], 0, 0, 0);
        }
      }
      const int qrel = wave * 32 + l31;
      if (own && (sub * 64 + 63 > wave * 32)) {
#pragma unroll
        for (int kt = 0; kt < 2; ++kt)
#pragma unroll
          for (int r = 0; r < 16; ++r) {
            const int krel = sub * 64 + kt * 32 + rm32(r, h);
            S[kt][r] = (krel <= qrel) ? S[kt][r] : -INFINITY;
          }
      }
      float mx = -INFINITY;
#pragma unroll
      for (int kt = 0; kt < 2; ++kt)
#pragma unroll
        for (int r = 0; r < 16; r += 2) mx = fmaxf(fmaxf(mx, S[kt][r]), S[kt][r + 1]);
      mx = fmaxf(mx, __shfl_xor(mx, 32));
      const bool need = first || (mx > 8.f);
      if (__ballot(need) != 0ull) {
        const float delta = need ? mx : 0.f;
        mref += delta;
#pragma unroll
        for (int kt = 0; kt < 2; ++kt)
#pragma unroll
          for (int r = 0; r < 16; ++r) S[kt][r] -= delta;
        if (!first) {
          const float alpha = __builtin_amdgcn_exp2f(-delta);
          lsum *= alpha;
#pragma unroll
          for (int d = 0; d < 2; ++d)
#pragma unroll
            for (int r = 0; r < 16; ++r) O[d][r] *= alpha;
        }
      }
      first = false;
      float ps = 0.f;
#pragma unroll
      for (int kt = 0; kt < 2; ++kt)
#pragma unroll
        for (int r = 0; r < 16; ++r) { S[kt][r] = __builtin_amdgcn_exp2f(S[kt][r]); ps += S[kt][r]; }
      lsum += ps;
#pragma unroll
      for (int kt = 0; kt < 2; ++kt)
#pragma unroll
        for (int sp = 0; sp < 2; ++sp) {
          u32x4 pw;
          pw.x = pk2(S[kt][8 * sp + 0], S[kt][8 * sp + 1]); pw.y = pk2(S[kt][8 * sp + 2], S[kt][8 * sp + 3]);
          pw.z = pk2(S[kt][8 * sp + 4], S[kt][8 * sp + 5]); pw.w = pk2(S[kt][8 * sp + 6], S[kt][8 * sp + 7]);
          const bf16x8 pb = __builtin_bit_cast(bf16x8, pw);
#pragma unroll
          for (int d = 0; d < 2; ++d) {
            const bf16x8 vf = *(const bf16x8*)(vs_ + d * 32 * LD + kt * 32 + sp * 16);
            O[d] = __builtin_amdgcn_mfma_f32_32x32x16_bf16(vf, pb, O[d], 0, 0, 0);
          }
        }
    }
    if (s + 1 < nsteps) swrite((s + 1) & 1);
    __syncthreads();
  }
  lsum += __shfl_xor(lsum, 32);
  const float inv = __builtin_amdgcn_rcpf(lsum);
  const int b = bh >> 3, hd = bh & 7;
  const size_t tok = (size_t)b * SEQ + qpos;
  const u16* ga = p.GA + tok * 512 + hd * 64;
  u16* yo = p.Ymix + tok * 1024 + hd * 64;
#pragma unroll
  for (int d = 0; d < 2; ++d)
#pragma unroll
    for (int rq = 0; rq < 4; ++rq) {
      const int c = d * 32 + 8 * rq + 4 * h;
      const u32x2 g = *(const u32x2*)(ga + c);
      u32x2 w;
      w.x = pk2(O[d][rq * 4 + 0] * inv * bflo(g.x), O[d][rq * 4 + 1] * inv * bfhi(g.x));
      w.y = pk2(O[d][rq * 4 + 2] * inv * bflo(g.y), O[d][rq * 4 + 3] * inv * bfhi(g.y));
      *(u32x2*)(yo + c) = w;
    }
}

template <bool SWA = false, bool SWB = false>
__device__ __forceinline__ void mm_nt(const u16* A, const u16* B, f32x4 (&acc)[2], int wave, int lane) {
  const int it = wave >> 1, jt0 = (wave & 1) * 2, r = lane & 15, g = lane >> 4;
#pragma unroll
  for (int ks = 0; ks < 2; ++ks) {
    const int ra = it * 16 + r;
    const int cha = SWA ? ((ks * 4 + g) ^ ((ra >> 3) & 7)) : (ks * 4 + g);
    const bf16x8 bfr = *(const bf16x8*)(A + ra * LD + cha * 8);
#pragma unroll
    for (int jj = 0; jj < 2; ++jj) {
      const int rb = (jt0 + jj) * 16 + r;
      const int chb = SWB ? ((ks * 4 + g) ^ ((rb >> 3) & 7)) : (ks * 4 + g);
      const bf16x8 afr = *(const bf16x8*)(B + rb * LD + chb * 8);
      acc[jj] = __builtin_amdgcn_mfma_f32_16x16x32_bf16(afr, bfr, acc[jj], 0, 0, 0);
    }
  }
}
__device__ __forceinline__ void zero2(f32x4 (&a)[2]) {
#pragma unroll
  for (int j = 0; j < 2; ++j)
#pragma unroll
    for (int e = 0; e < 4; ++e) a[j][e] = 0.f;
}

struct PrepRaw { u32x4 cur[5]; };
__device__ __forceinline__ void prep_load(const Params& p, int item, PrepRaw& rw) {
  const int tid = threadIdx.x;
  const int b = item >> 9, hd = (item >> 6) & 7, c = item & 63;
  const int t = tid >> 3, cg8 = (tid & 7) * 8;
  const u16* prow = p.PB + ((size_t)b * SEQ + c * 64 + t) * PBW;
  rw.cur[0] = *(const u32x4*)(prow + hd * 64 + cg8);
  rw.cur[1] = *(const u32x4*)(prow + 512 + hd * 64 + cg8);
  rw.cur[2] = *(const u32x4*)(prow + 1024 + hd * 64 + cg8);
  rw.cur[3] = *(const u32x4*)(prow + 1536 + cg8);
  rw.cur[4] = *(const u32x4*)(prow + 1600 + cg8);
}
__device__ void rwkv_prep_item(const Params& p, char* lds_, int item, PrepRaw& raw, int next_item) {
  char* lds = lds_ + 256;
  const int tid = threadIdx.x, lane = tid & 63, wave = tid >> 6;
  const int b = item >> 9, hd = (item >> 6) & 7, c = item & 63;
  constexpr int RB = 64 * LD * 2;
  u16* At = (u16*)(lds + 0 * RB);  u16* Bt = (u16*)(lds + 1 * RB);  u16* Kt = (u16*)(lds + 2 * RB);  u16* Rt = (u16*)(lds + 3 * RB);
  u16* AT = (u16*)(lds + 4 * RB);  u16* BT = (u16*)(lds + 5 * RB);  u16* KT = (u16*)(lds + 6 * RB);  u16* VT = (u16*)(lds + 7 * RB);
  u16* LAK = (u16*)(lds + 8 * RB); u16* MRB = (u16*)(lds + 9 * RB); u16* MRK = (u16*)(lds + 10 * RB); u16* TB = (u16*)(lds + 11 * RB);
  float* Tf = (float*)(lds + 12 * RB);
  float* gC = (float*)(lds + 12 * RB + 64 * 68 * 4);
  float* Za = (float*)(lds + 12 * RB + 64 * 68 * 4 + 256);
  u16* X1T = At; u16* WT = Bt; u16* U0T = Kt;
  u16* TW = LAK; u16* AD = MRB; u16* DUs = MRK; u16* IUs = TB;
  float* Zw = Tf; float* G = Tf;

  const int t = tid >> 3, cg8 = (tid & 7) * 8;
  const int pos = c * 64 + t;
  const size_t tokrow = (size_t)b * SEQ + pos;
  const u16* prow = p.PB + tokrow * PBW;
  const bool hasprev = pos > 0;
  float rr[8], kk_[8], vv[8];
  f32x4 pdb[2], pib[2], pkk[2], pka[2], prk[2];
  {
    const int cbp = hd * 64 + cg8;
#pragma unroll
    for (int q = 0; q < 2; ++q) {
      pdb[q] = *(const f32x4*)(p.decay_bias + cbp + 4 * q); pib[q] = *(const f32x4*)(p.iclr_bias + cbp + 4 * q);
      pkk[q] = *(const f32x4*)(p.k_k + cbp + 4 * q); pka[q] = *(const f32x4*)(p.k_a + cbp + 4 * q); prk[q] = *(const f32x4*)(p.r_k + cbp + 4 * q);
    }
  }
  __syncthreads();
  {
    auto ldshift = [&](int col, float (&o)[8], const u32x4 cur) {
      u32x4 prv; prv.x = prv.y = prv.z = prv.w = 0u;
      if (hasprev) prv = *(const u32x4*)(prow - PBW + col);
      const f32x4 m0 = *(const f32x4*)(p.shift_mu + col), m1 = *(const f32x4*)(p.shift_mu + col + 4);
      const unsigned cw[4] = {cur.x, cur.y, cur.z, cur.w}, pw[4] = {prv.x, prv.y, prv.z, prv.w};
#pragma unroll
      for (int q = 0; q < 4; ++q) {
        const float c0 = bflo(cw[q]), c1 = bfhi(cw[q]), p0 = bflo(pw[q]), p1 = bfhi(pw[q]);
        const float mu0 = (q < 2) ? m0[2 * q] : m1[2 * q - 4], mu1 = (q < 2) ? m0[2 * q + 1] : m1[2 * q - 3];
        o[2 * q] = c0 + (p0 - c0) * mu0;
        o[2 * q + 1] = c1 + (p1 - c1) * mu1;
      }
    };
    ldshift(hd * 64 + cg8, rr, raw.cur[0]);
    ldshift(512 + hd * 64 + cg8, kk_, raw.cur[1]);
    ldshift(1024 + hd * 64 + cg8, vv, raw.cur[2]);
    float wd[8], ad[8];
    ldshift(1536 + cg8, wd, raw.cur[3]);
    ldshift(1600 + cg8, ad, raw.cur[4]);
    u32x4 w;
    float th[8];
#pragma unroll
    for (int e = 0; e < 8; ++e) th[e] = 1.f - 2.f * __builtin_amdgcn_rcpf(1.f + fexp(2.f * wd[e]));
    w.x = pk2(th[0], th[1]); w.y = pk2(th[2], th[3]); w.z = pk2(th[4], th[5]); w.w = pk2(th[6], th[7]);
    *(u32x4*)(TW + t * LD + cg8) = w;
    w.x = pk2(ad[0], ad[1]); w.y = pk2(ad[2], ad[3]); w.z = pk2(ad[4], ad[5]); w.w = pk2(ad[6], ad[7]);
    *(u32x4*)(AD + t * LD + cg8) = w;
    *(u32x4*)(DUs + t * LD + cg8) = *(const u32x4*)(p.DUt + (size_t)(hd * 64 + t) * 64 + cg8);
    *(u32x4*)(IUs + t * LD + cg8) = *(const u32x4*)(p.IUt + (size_t)(hd * 64 + t) * 64 + cg8);
  }
  __syncthreads();
  const int it = wave >> 1, jt0 = (wave & 1) * 2, mr = lane & 15, mg = lane >> 4;
  const int mi = it * 16 + mr;
  {
    f32x4 a1[2], a2[2]; zero2(a1); zero2(a2);
    mm_nt(TW, DUs, a1, wave, lane);
    mm_nt(AD, IUs, a2, wave, lane);
#pragma unroll
    for (int jj = 0; jj < 2; ++jj) {
      *(f32x4*)(Zw + mi * 68 + (jt0 + jj) * 16 + 4 * mg) = a1[jj];
      *(f32x4*)(Za + mi * 68 + (jt0 + jj) * 16 + 4 * mg) = a2[jj];
    }
  }
  __syncthreads();
  float av[8], bv[8], k2[8], lw[8];
  float bon;
  {
    float ss = 0.f; bon = 0.f;
    float kk[8], ai[8];
#pragma unroll
    for (int e = 0; e < 8; ++e) {
      const float zw = Zw[t * 68 + cg8 + e] + pdb[e >> 2][e & 3];
      const float za = Za[t * 68 + cg8 + e] + pib[e >> 2][e & 3];
      lw[e] = -0.6065306597126334f * fsigmoid(zw);
      ai[e] = fsigmoid(za);
      kk[e] = kk_[e] * pkk[e >> 2][e & 3];
      k2[e] = kk_[e] * (1.f + (ai[e] - 1.f) * pka[e >> 2][e & 3]);
      ss += kk[e] * kk[e];
      bon += rr[e] * k2[e] * prk[e >> 2][e & 3];
    }
    ss += __shfl_xor(ss, 1); ss += __shfl_xor(ss, 2); ss += __shfl_xor(ss, 4);
    bon += __shfl_xor(bon, 1); bon += __shfl_xor(bon, 2); bon += __shfl_xor(bon, 4);
    const float inv = __builtin_amdgcn_rsqf(fmaxf(ss, 1e-24f));
#pragma unroll
    for (int e = 0; e < 8; ++e) { const float kn = kk[e] * inv; av[e] = -kn; bv[e] = kn * ai[e]; }
  }
  __builtin_amdgcn_sched_barrier(0);
  if (next_item < 4096) prep_load(p, next_item, raw);
  __builtin_amdgcn_sched_barrier(0);
  __syncthreads();
#pragma unroll
  for (int e = 0; e < 8; ++e) G[t * 68 + cg8 + e] = lw[e];
  __syncthreads();
  {
    const int d = tid & 63, seg = tid >> 6;
    float s = 0.f;
#pragma unroll
    for (int q = 0; q < 8; ++q) s += G[(seg * 8 + q) * 68 + d];
    Za[seg * 64 + d] = s;
  }
  __syncthreads();
  {
    const int d = tid & 63, seg = tid >> 6;
    float pre = 0.f;
    for (int q = 0; q < seg; ++q) pre += Za[q * 64 + d];
#pragma unroll
    for (int q = 0; q < 8; ++q) { pre += G[(seg * 8 + q) * 68 + d]; G[(seg * 8 + q) * 68 + d] = pre; }
  }
  __syncthreads();
  {
    float a_[8], b_[8], k_[8], r_[8];
#pragma unroll
    for (int e = 0; e < 8; ++e) {
      const float g = G[t * 68 + cg8 + e];
      const float eg = fexp(g), egm = fexp(g - lw[e]), ei = fexp(-g);
      a_[e] = av[e] * egm; b_[e] = bv[e] * ei; k_[e] = k2[e] * ei; r_[e] = rr[e] * eg;
      if (t == 63) gC[cg8 + e] = eg;
    }
    auto put = [&](u16* rowm, u16* trans, const float (&f)[8]) {
      const unsigned wv[4] = {pk2(f[0], f[1]), pk2(f[2], f[3]), pk2(f[4], f[5]), pk2(f[6], f[7])};
      if (rowm) { u32x4 w4; w4.x = wv[0]; w4.y = wv[1]; w4.z = wv[2]; w4.w = wv[3]; *(u32x4*)(rowm + t * LD + cg8) = w4; }
      if (trans) {
#pragma unroll
        for (int e = 0; e < 8; ++e) trans[(cg8 + e) * LD + (((t >> 3) ^ (cg8 >> 3)) << 3) + (t & 7)] = (u16)((e & 1) ? (wv[e >> 1] >> 16) : (wv[e >> 1] & 0xffffu));
      }
    };
    put(At, AT, a_); put(Bt, BT, b_); put(Kt, KT, k_); put(Rt, nullptr, r_); put(nullptr, VT, vv);
    u32x4 w;
    w.x = pk2(bon * vv[0], bon * vv[1]); w.y = pk2(bon * vv[2], bon * vv[3]); w.z = pk2(bon * vv[4], bon * vv[5]); w.w = pk2(bon * vv[6], bon * vv[7]);
    *(u32x4*)(p.BV + (size_t)item * 4096 + t * 64 + cg8) = w;
  }
  __syncthreads();
  {
    f32x4 lab[2], lak[2], mrb[2], mrk[2]; zero2(lab); zero2(lak); zero2(mrb); zero2(mrk);
    mm_nt(At, Bt, lab, wave, lane);
    mm_nt(At, Kt, lak, wave, lane);
    mm_nt(Rt, Bt, mrb, wave, lane);
    mm_nt(Rt, Kt, mrk, wave, lane);
#pragma unroll
    for (int jj = 0; jj < 2; ++jj) {
      const int j0 = (jt0 + jj) * 16 + 4 * mg;
      f32x4 o; float x1[4], x2[4], x3[4];
#pragma unroll
      for (int e = 0; e < 4; ++e) {
        const int j = j0 + e;
        o[e] = (j < mi) ? lab[jj][e] : 0.f;
        x1[e] = (j < mi) ? lak[jj][e] : 0.f;
        x2[e] = (j <= mi) ? mrb[jj][e] : 0.f;
        x3[e] = (j <= mi) ? mrk[jj][e] : 0.f;
      }
      *(f32x4*)(Tf + mi * 68 + j0) = o;
      u32x2 w;
      w.x = pk2(x1[0], x1[1]); w.y = pk2(x1[2], x1[3]); *(u32x2*)(LAK + mi * LD + j0) = w;
      w.x = pk2(x2[0], x2[1]); w.y = pk2(x2[2], x2[3]); *(u32x2*)(MRB + mi * LD + j0) = w;
      w.x = pk2(x3[0], x3[1]); w.y = pk2(x3[2], x3[3]); *(u32x2*)(MRK + mi * LD + j0) = w;
    }
  }
  __syncthreads();
  {
    float* Ms = Za;
    const int r16 = lane & 15, g4 = lane >> 4;
    if (wave == 0) {
      const float* Lk = Tf + (16 * g4) * 68 + 16 * g4;
      float xv[16];
#pragma unroll
      for (int i = 0; i < 16; ++i) {
        float sacc = (i == r16) ? 1.f : 0.f;
#pragma unroll
        for (int q = 0; q < (i + 3) / 4; ++q) {
          const f32x4 Lv = *(const f32x4*)(Lk + i * 68 + 4 * q);
#pragma unroll
          for (int e = 0; e < 4; ++e)
            if (4 * q + e < i) sacc += Lv[e] * xv[4 * q + e];
        }
        xv[i] = sacc;
      }
      float* Dk = Tf + (16 * g4) * 68 + 16 * g4 + r16;
#pragma unroll
      for (int i = 0; i < 16; ++i) Dk[i * 68] = xv[i];
    }
    __syncthreads();
    if (wave < 2) {
      const int R = 32 * wave + 16, C = 32 * wave;
      f32x4 m = {0.f, 0.f, 0.f, 0.f};
#pragma unroll
      for (int ks = 0; ks < 4; ++ks)
        m = __builtin_amdgcn_mfma_f32_16x16x4f32(Tf[(R + r16) * 68 + C + 4 * ks + g4], Tf[(C + 4 * ks + g4) * 68 + C + r16], m, 0, 0, 0);
      float* mw = Ms + wave * 16 * 17;
#pragma unroll
      for (int e = 0; e < 4; ++e) mw[(4 * g4 + e) * 17 + r16] = m[e];
      f32x4 t = {0.f, 0.f, 0.f, 0.f};
#pragma unroll
      for (int ks = 0; ks < 4; ++ks)
        t = __builtin_amdgcn_mfma_f32_16x16x4f32(Tf[(R + r16) * 68 + R + 4 * ks + g4], mw[(4 * ks + g4) * 17 + r16], t, 0, 0, 0);
#pragma unroll
      for (int e = 0; e < 4; ++e) Tf[(R + 4 * g4 + e) * 68 + C + r16] = t[e];
    }
    __syncthreads();
    float* M2 = Ms + 2 * 16 * 17;
    const int ti = (wave >> 1) & 1, tj = wave & 1;
    if (wave < 4) {
      f32x4 m = {0.f, 0.f, 0.f, 0.f};
#pragma unroll
      for (int ks = 0; ks < 8; ++ks)
        m = __builtin_amdgcn_mfma_f32_16x16x4f32(Tf[(32 + 16 * ti + r16) * 68 + 4 * ks + g4], Tf[(4 * ks + g4) * 68 + 16 * tj + r16], m, 0, 0, 0);
#pragma unroll
      for (int e = 0; e < 4; ++e) M2[(16 * ti + 4 * g4 + e) * 33 + 16 * tj + r16] = m[e];
    }
    __syncthreads();
    if (wave < 4) {
      f32x4 t = {0.f, 0.f, 0.f, 0.f};
#pragma unroll
      for (int ks = 0; ks < 8; ++ks)
        t = __builtin_amdgcn_mfma_f32_16x16x4f32(Tf[(32 + 16 * ti + r16) * 68 + 32 + 4 * ks + g4], M2[(4 * ks + g4) * 33 + 16 * tj + r16], t, 0, 0, 0);
#pragma unroll
      for (int e = 0; e < 4; ++e) Tf[(32 + 16 * ti + 4 * g4 + e) * 68 + 16 * tj + r16] = t[e];
    }
    __syncthreads();
    {
      const float* tr = Tf + t * 68 + cg8;
      u32x4 w; w.x = pk2(tr[0], tr[1]); w.y = pk2(tr[2], tr[3]); w.z = pk2(tr[4], tr[5]); w.w = pk2(tr[6], tr[7]);
      *(u32x4*)(TB + t * LD + cg8) = w;
    }
  }
  __syncthreads();
  {
    f32x4 a1[2], a2[2]; zero2(a1); zero2(a2);
    mm_nt<true, false>(VT, LAK, a1, wave, lane);
    mm_nt<true, false>(AT, TB, a2, wave, lane);
#pragma unroll
    for (int jj = 0; jj < 2; ++jj) {
      const int j0 = (jt0 + jj) * 16 + 4 * mg;
      u32x2 w;
      w.x = pk2(a1[jj][0], a1[jj][1]); w.y = pk2(a1[jj][2], a1[jj][3]); *(u32x2*)(X1T + mi * LD + j0) = w;
      w.x = pk2(a2[jj][0], a2[jj][1]); w.y = pk2(a2[jj][2], a2[jj][3]); *(u32x2*)(WT + mi * LD + j0) = w;
    }
  }
  __syncthreads();
  {
    f32x4 a1[2]; zero2(a1);
    mm_nt(X1T, TB, a1, wave, lane);
#pragma unroll
    for (int jj = 0; jj < 2; ++jj) {
      const int j0 = (jt0 + jj) * 16 + 4 * mg;
      u32x2 w; w.x = pk2(a1[jj][0], a1[jj][1]); w.y = pk2(a1[jj][2], a1[jj][3]); *(u32x2*)(U0T + mi * LD + j0) = w;
    }
  }
  __syncthreads();
  {
    f32x4 pp[2], qt[2], ry[2], y0[2]; zero2(pp); zero2(qt); zero2(ry); zero2(y0);
    mm_nt<true, false>(BT, WT, pp, wave, lane);
    mm_nt<false, true>(U0T, BT, qt, wave, lane); mm_nt<true, true>(VT, KT, qt, wave, lane);
    mm_nt(MRB, WT, ry, wave, lane);
#if DBG_Y0 == 1
    mm_nt<false, true>(MRK, VT, y0, wave, lane);
#elif DBG_Y0 == 2
    mm_nt(MRB, U0T, y0, wave, lane);
#elif DBG_Y0 == 5
    mm_nt(MRB, X1T, y0, wave, lane);
#elif DBG_Y0 == 3
    mm_nt(MRB, VT, y0, wave, lane);
#elif DBG_Y0 == 4
    mm_nt(MRK, U0T, y0, wave, lane);
#else
    mm_nt(MRB, U0T, y0, wave, lane); mm_nt<false, true>(MRK, VT, y0, wave, lane);
#endif
    const float gci = gC[mi];
#pragma unroll
    for (int jj = 0; jj < 2; ++jj) {
      const int jt = jt0 + jj, j0 = jt * 16 + 4 * mg;
      float pv[4];
#pragma unroll
      for (int e = 0; e < 4; ++e) pv[e] = gci * (pp[jj][e] + ((j0 + e) == mi ? 1.f : 0.f));
      u32x2 w; w.x = pk2(pv[0], pv[1]); w.y = pk2(pv[2], pv[3]);
      *(u32x2*)(p.Pm + (size_t)item * 4096 + mi * 64 + (jt >> 1) * 32 + 8 * mg + 4 * (jt & 1)) = w;
      const f32x4 gj = *(const f32x4*)(gC + j0);
      { u32x2 qw; qw.x = pk2(qt[jj][0] * gj[0], qt[jj][1] * gj[1]); qw.y = pk2(qt[jj][2] * gj[2], qt[jj][3] * gj[3]);
        *(u32x2*)(p.QT + (size_t)item * 4096 + mi * 64 + j0) = qw; }
      const u32x2 rw = *(const u32x2*)(Rt + mi * LD + j0);
      w.x = pk2(ry[jj][0] + bflo(rw.x), ry[jj][1] + bfhi(rw.x)); w.y = pk2(ry[jj][2] + bflo(rw.y), ry[jj][3] + bfhi(rw.y));
      *(u32x2*)(p.Ry + (size_t)item * 4096 + mi * 64 + j0) = w;
#if DBG_DUMP
      { const u32x2 dw = *(const u32x2*)(DBG_DUMP_SRC + mi * LD + j0); y0[jj][0] = bflo(dw.x); y0[jj][1] = bfhi(dw.x); y0[jj][2] = bflo(dw.y); y0[jj][3] = bfhi(dw.y); }
#endif
      { u32x2 yw; yw.x = pk2(y0[jj][0], y0[jj][1]); yw.y = pk2(y0[jj][2], y0[jj][3]);
        *(u32x2*)(p.Y0 + (size_t)item * 4096 + mi * 64 + j0) = yw; }
    }
  }
}

__device__ void phase_mix(const Params& p, char* lds, int bid, int nb) {
  PrepRaw raw;
  if (bid < 4096) prep_load(p, bid, raw);
  for (int item = bid; item < 4096; item += nb) rwkv_prep_item(p, lds, item, raw, item + nb);
}
__device__ void phase_attn_queue(const Params& p, char* lds, int bid, int nb) {
  int* slot = (int*)(lds + LDS_BYTES - 16);
  const int xcd = bid & 7;
  for (;;) {
    __syncthreads();
    if (threadIdx.x == 0) *slot = atomicAdd(p.qctr + xcd * 8, 1);
    __syncthreads();
    const int idx = *slot;
    if (idx >= 128) break;
    const int qi = 15 - (idx >> 3), bh = (idx & 7) * 8 + xcd;
    attn_item(p, lds, bh, qi);
  }
}

__device__ void phase_attn_only(const Params& p, char* lds, int bid, int nb) {
  for (int L = bid; L < 1024; L += nb) {
    const int round = L >> 8, pos = L & 255, grp = pos >> 6, bh = pos & 63;
    const int qi = (round == 0) ? 15 - grp : (round == 1) ? 8 + grp : (round == 2) ? 7 - grp : grp;
    attn_item(p, lds, bh, qi);
  }
}
__device__ void phase_prep_only(const Params& p, char* lds, int bid, int nb) {
  PrepRaw raw;
  if (bid < 4096) prep_load(p, bid, raw);
  for (int item = bid; item < 4096; item += nb) rwkv_prep_item(p, lds, item, raw, item + nb);
}
__device__ void phase_scan(const Params& p, int bid, int nb) {
  const int tid = threadIdx.x, lane = tid & 63, wave = tid >> 6;
  const int r = lane & 15, g = lane >> 4;
  const int nsb = nb < 32 ? nb : 32;
  if (bid >= nsb) return;
  for (int chain = bid * 8 + wave; chain < 256; chain += nsb * 8) {
    const int bh = chain >> 2, v0 = (chain & 3) * 16;
    f32x4 acc[4];
#pragma unroll
    for (int m = 0; m < 4; ++m)
#pragma unroll
      for (int e = 0; e < 4; ++e) acc[m][e] = 0.f;
    struct Buf { bf16x8 pf[4][2]; u32x2 qv[4]; };
    Buf b0, b1, b2;
    auto loadc = [&](Buf& bb, int c) {
      const size_t item = (size_t)bh * 64 + c;
#pragma unroll
      for (int m = 0; m < 4; ++m) {
#pragma unroll
        for (int ks = 0; ks < 2; ++ks) bb.pf[m][ks] = *(const bf16x8*)(p.Pm + item * 4096 + (m * 16 + r) * 64 + ks * 32 + g * 8);
        bb.qv[m] = *(const u32x2*)(p.QT + item * 4096 + (v0 + r) * 64 + m * 16 + 4 * g);
      }
    };
    auto step = [&](const Buf& bb, int c) {
      const size_t item = (size_t)bh * 64 + c;
      bf16x8 hb[2];
#pragma unroll
      for (int ks = 0; ks < 2; ++ks) {
        u32x4 w;
        w.x = pk2(acc[2 * ks][0], acc[2 * ks][1]); w.y = pk2(acc[2 * ks][2], acc[2 * ks][3]);
        w.z = pk2(acc[2 * ks + 1][0], acc[2 * ks + 1][1]); w.w = pk2(acc[2 * ks + 1][2], acc[2 * ks + 1][3]);
        hb[ks] = __builtin_bit_cast(bf16x8, w);
        u32x2 lo, hi; lo.x = w.x; lo.y = w.y; hi.x = w.z; hi.y = w.w;
        *(u32x2*)(p.Hs + item * 4096 + (v0 + r) * 64 + (2 * ks) * 16 + 4 * g) = lo;
        *(u32x2*)(p.Hs + item * 4096 + (v0 + r) * 64 + (2 * ks + 1) * 16 + 4 * g) = hi;
      }
#pragma unroll
      for (int m = 0; m < 4; ++m) {
        acc[m][0] = bflo(bb.qv[m].x); acc[m][1] = bfhi(bb.qv[m].x); acc[m][2] = bflo(bb.qv[m].y); acc[m][3] = bfhi(bb.qv[m].y);
#pragma unroll
        for (int ks = 0; ks < 2; ++ks) acc[m] = __builtin_amdgcn_mfma_f32_16x16x32_bf16(bb.pf[m][ks], hb[ks], acc[m], 0, 0, 0);
      }
    };
    loadc(b0, 0); loadc(b1, 1);
    for (int c = 0; c < 63; c += 3) {
      loadc(b2, c + 2); __builtin_amdgcn_sched_barrier(0);
      step(b0, c); __builtin_amdgcn_sched_barrier(0);
      loadc(b0, c + 3); __builtin_amdgcn_sched_barrier(0);
      step(b1, c + 1); __builtin_amdgcn_sched_barrier(0);
      if (c + 4 < 64) loadc(b1, c + 4);
      __builtin_amdgcn_sched_barrier(0);
      step(b2, c + 2); __builtin_amdgcn_sched_barrier(0);
    }
    step(b0, 63);
  }
}

__device__ void phase_rwkv_out(const Params& p, int bid, int nb) {
  const int tid = threadIdx.x, lane = tid & 63, wave = tid >> 6;
  const int r = lane & 15, g = lane >> 4, wq = wave & 3;
  for (int it2 = bid; it2 < 2048; it2 += nb) {
    const int item = it2 * 2 + (wave >> 2);
    const int b = item >> 9, hd = (item >> 6) & 7, c = item & 63;
    const int tl = wq * 16 + r;
    const u16* ryp = p.Ry + (size_t)item * 4096 + tl * 64;
    const u16* hsp = p.Hs + (size_t)item * 4096;
    f32x4 acc[4];
#pragma unroll
    for (int jt = 0; jt < 4; ++jt) { const u32x2 yw = *(const u32x2*)(p.Y0 + (size_t)item * 4096 + tl * 64 + jt * 16 + 4 * g); acc[jt][0] = bflo(yw.x); acc[jt][1] = bfhi(yw.x); acc[jt][2] = bflo(yw.y); acc[jt][3] = bfhi(yw.y); }
#pragma unroll
    for (int ks = 0; ks < 2; ++ks) {
      const bf16x8 bfr = *(const bf16x8*)(ryp + ks * 32 + g * 8);
#pragma unroll
      for (int jt = 0; jt < 4; ++jt) {
        const bf16x8 afr = *(const bf16x8*)(hsp + (jt * 16 + r) * 64 + ks * 32 + g * 8);
#if !DBG_NOHS
        acc[jt] = __builtin_amdgcn_mfma_f32_16x16x32_bf16(afr, bfr, acc[jt], 0, 0, 0);
#endif
      }
    }
    float s = 0.f;
#pragma unroll
    for (int jt = 0; jt < 4; ++jt)
#pragma unroll
      for (int e = 0; e < 4; ++e) s += acc[jt][e];
    s += __shfl_xor(s, 16); s += __shfl_xor(s, 32);
    const float mu = s * (1.f / 64.f);
    float vs = 0.f;
#pragma unroll
    for (int jt = 0; jt < 4; ++jt)
#pragma unroll
      for (int e = 0; e < 4; ++e) { const float d = acc[jt][e] - mu; vs += d * d; }
    vs += __shfl_xor(vs, 16); vs += __shfl_xor(vs, 32);
    const float rstd = __builtin_amdgcn_rsqf(vs * (1.f / 64.f) + 64e-5f);
    const size_t tok = (size_t)b * SEQ + c * 64 + tl;
#pragma unroll
    for (int jt = 0; jt < 4; ++jt) {
      const int v = jt * 16 + 4 * g, cc = hd * 64 + v;
      const f32x4 gg = *(const f32x4*)(p.gn_gain + cc), gb = *(const f32x4*)(p.gn_bias + cc);
      const u32x2 bvw = *(const u32x2*)(p.BV + (size_t)item * 4096 + tl * 64 + v);
      const u32x2 gw = *(const u32x2*)(p.GB + tok * 512 + cc);
      float o[4];
      const float bvf[4] = {bflo(bvw.x), bfhi(bvw.x), bflo(bvw.y), bfhi(bvw.y)};
      const float gf[4] = {bflo(gw.x), bfhi(gw.x), bflo(gw.y), bfhi(gw.y)};
#pragma unroll
      for (int e = 0; e < 4; ++e) {
#if DBG_P4 == 1
        o[e] = bvf[e] * gf[e];
#elif DBG_P4 == 2
        o[e] = ((acc[jt][e] - mu) * rstd * gg[e] + gb[e]) * gf[e];
#else
        o[e] = ((acc[jt][e] - mu) * rstd * gg[e] + gb[e] + bvf[e]) * gf[e];
#endif
      }
      u32x2 w; w.x = pk2(o[0], o[1]); w.y = pk2(o[2], o[3]);
      *(u32x2*)(p.Ymix + tok * 1024 + 512 + cc) = w;
    }
  }
}


#define XB_TMO      128
#define XB_XCNT(j)  (256  + 64 * (j))
#define XB_XSUB(j)  (1280 + 64 * (j))
#define XB_XGEN(j)  (2304 + 64 * (j))
#define XB_TOP      3328
#define XB_TOPGEN   3392
#define XCD_BAR_WORDS 3456
#define XB_SPIN_CAP (1u << 18)
#define LAS __attribute__((address_space(3)))
__device__ __forceinline__ unsigned xb_ld(unsigned* p)              { return __hip_atomic_load(p, __ATOMIC_RELAXED, __HIP_MEMORY_SCOPE_AGENT); }
__device__ __forceinline__ unsigned xb_add(unsigned* p, unsigned v) { return __hip_atomic_fetch_add(p, v, __ATOMIC_RELAXED, __HIP_MEMORY_SCOPE_AGENT); }
__device__ __forceinline__ unsigned xb_xcc_id() { return (unsigned)__builtin_amdgcn_s_getreg((3 << 11) | 20) & 0xFu; }
#define XB_SPIN(cond, bar) do { unsigned _sp = 0; while (cond) { __builtin_amdgcn_s_sleep(1); \
    if ((++_sp & 255u) == 0u) { if (xb_ld(&(bar)[XB_TMO])) break; if (_sp > XB_SPIN_CAP) { atomicAdd(&(bar)[XB_TMO], 1u); break; } } } } while (0)
struct XcdBarrier { unsigned* bar; unsigned x; volatile LAS unsigned* st; };
__device__ __forceinline__ XcdBarrier xcd_barrier_post(unsigned* bar, volatile LAS unsigned* st) {
    XcdBarrier b; b.bar = bar; b.x = xb_xcc_id(); b.st = st;
    if (threadIdx.x == 0) (void)xb_add(&bar[XB_XCNT(b.x)], 1u);
    return b;
}
__device__ __forceinline__ void xcd_barrier_complete(unsigned* bar, unsigned x, unsigned& nloc, unsigned& nx) {
    const unsigned G = gridDim.x * gridDim.y * gridDim.z;
    unsigned sum, cnt, mine, sp = 0u;
    for (;;) {
        sum = 0u; cnt = 0u; mine = 0u;
#pragma unroll
        for (unsigned j = 0; j < 16; ++j) { const unsigned c = xb_ld(&bar[XB_XCNT(j)]); sum += c; cnt += (c > 0u) ? 1u : 0u; mine = (j == x) ? c : mine; }
        if (sum == G) break;
        __builtin_amdgcn_s_sleep(1);
        if ((++sp & 255u) == 0u) { if (xb_ld(&bar[XB_TMO])) break; if (sp > XB_SPIN_CAP) { atomicAdd(&bar[XB_TMO], 1u); break; } }
    }
    nloc = mine > 0u ? mine : 1u; nx = cnt > 0u ? cnt : 1u;
}
__device__ __forceinline__ void xcd_barrier(const XcdBarrier& b) {
    asm volatile("s_waitcnt vmcnt(0)" ::: "memory");
    __syncthreads();
    if (threadIdx.x == 0) {
        unsigned* bar = b.bar;
        __builtin_amdgcn_s_waitcnt(0);
        unsigned nloc = b.st[0], nx = b.st[1];
        if (nloc == 0u) { xcd_barrier_complete(bar, b.x, nloc, nx); b.st[0] = nloc; b.st[1] = nx; }
        const unsigned old = xb_add(&bar[XB_XSUB(b.x)], 1u);
        const unsigned gen = old / nloc;
        if (old + 1u == (gen + 1u) * nloc) {
            __builtin_amdgcn_fence(__ATOMIC_RELEASE, "agent");
            asm volatile("s_waitcnt vmcnt(0)" ::: "memory");
            const unsigned og = xb_add(&bar[XB_TOP], 1u);
            const unsigned tg = og / nx;
            if (og + 1u == (tg + 1u) * nx) xb_add(&bar[XB_TOPGEN], 1u);
            else XB_SPIN(xb_ld(&bar[XB_TOPGEN]) == tg, bar);
            __builtin_amdgcn_fence(__ATOMIC_ACQUIRE, "agent");
            xb_add(&bar[XB_XGEN(b.x)], 1u);
            asm volatile("s_waitcnt vmcnt(0)" ::: "memory");
        } else {
            XB_SPIN(xb_ld(&bar[XB_XGEN(b.x)]) == gen, bar);
            __builtin_amdgcn_fence(__ATOMIC_ACQUIRE, "agent");
            asm volatile("s_waitcnt vmcnt(0)" ::: "memory");
        }
    }
    __syncthreads();
}

extern __shared__ __attribute__((aligned(16))) char dyn_lds[];

__global__ void __launch_bounds__(NT) fwd_mega(Params p) {
  cg::grid_group grid = cg::this_grid();
  const int bid = blockIdx.x, nb = gridDim.x;
  volatile LAS unsigned* xst = (volatile LAS unsigned*)(dyn_lds + LDS_BYTES - 32);
  if (threadIdx.x == 0) { xst[0] = 0u; xst[1] = 0u; }
  __syncthreads();
  const XcdBarrier xb = xcd_barrier_post(p.xbar, xst);
  phase_prep(p, dyn_lds, bid, nb);
  xcd_barrier(xb);
#if REP == 7 || REP == 8
  phase_gemm1(p, dyn_lds, bid, nb, REP - 6);
  xcd_barrier(xb);
#endif
  phase_gemm1(p, dyn_lds, bid, nb);
#if REP == 1
  xcd_barrier(xb);
  phase_gemm1(p, dyn_lds, bid, nb);
#endif
  xcd_barrier(xb);
  phase_mix(p, dyn_lds, bid, nb);
#if REP == 3
  __syncthreads();
  phase_prep_only(p, dyn_lds, bid, nb);
#endif
  xcd_barrier(xb);
  phase_scan(p, bid, nb);
#if REP == 10
  xcd_barrier(xb);
#endif
#if REP == 9
  phase_scan(p, bid, nb);
  phase_scan(p, bid, nb);
  phase_scan(p, bid, nb);
  phase_scan(p, bid, nb);
#endif
  phase_attn_queue(p, dyn_lds, bid, nb);
  xcd_barrier(xb);
  phase_rwkv_out(p, bid, nb);
  xcd_barrier(xb);
  const bool fused = (nb & 31) == 0;
  phase_gemm2(p, dyn_lds, bid, nb, fused);
  if (!fused) {
    grid.sync();
    phase_final(p, bid, nb);
  }
}

#if N_LAUNCH_SPLIT
__global__ void __launch_bounds__(NT) k_prep(Params p) { phase_prep(p, dyn_lds, blockIdx.x, gridDim.x); }
__global__ void __launch_bounds__(NT) k_gemm1(Params p) { phase_gemm1(p, dyn_lds, blockIdx.x, gridDim.x); }
__global__ void __launch_bounds__(NT) k_mix(Params p) { phase_mix(p, dyn_lds, blockIdx.x, gridDim.x); }
__global__ void __launch_bounds__(NT) k_scan(Params p) { phase_scan(p, blockIdx.x, gridDim.x); phase_attn_queue(p, dyn_lds, blockIdx.x, gridDim.x); }
__global__ void __launch_bounds__(NT) k_rout(Params p) { phase_rwkv_out(p, blockIdx.x, gridDim.x); }
__global__ void __launch_bounds__(NT) k_gemm2(Params p) { phase_gemm2(p, dyn_lds, blockIdx.x, gridDim.x, false); }
__global__ void __launch_bounds__(NT) k_final(Params p) { phase_final(p, blockIdx.x, gridDim.x); }
#endif

extern "C" void kernel_launch(void* const* d_in, const int* in_sizes, int n_in, void* d_out, int out_size, void* d_ws, size_t ws_size, hipStream_t stream) {
  Params p{};
  p.x = (const float*)d_in[0]; p.norm_gain = (const float*)d_in[1]; p.w_in = (const float*)d_in[2]; p.shift_mu = (const float*)d_in[3];
  p.decay_bias = (const float*)d_in[4]; p.decay_up = (const float*)d_in[5]; p.iclr_bias = (const float*)d_in[6]; p.iclr_up = (const float*)d_in[7];
  p.k_k = (const float*)d_in[8]; p.k_a = (const float*)d_in[9]; p.r_k = (const float*)d_in[10]; p.gn_gain = (const float*)d_in[11]; p.gn_bias = (const float*)d_in[12];
  p.w_out = (const float*)d_in[13]; p.final_gain = (const float*)d_in[14];
  p.out = (float*)d_out;
  char* w = (char*)d_ws; size_t off = 0;
  auto take = [&](size_t bytes) { char* r = w + off; off += (bytes + 255) & ~(size_t)255; return r; };
  char* r1 = take((size_t)TOK * DM * 2);
  p.xb = (u16*)r1; p.Pm = (u16*)r1; p.Ry = (u16*)(r1 + (size_t)4096 * 4096 * 2);
  p.winT = (u16*)take((size_t)INW * DM * 2);
  p.woutT = (u16*)take((size_t)DM * DM * 2);
  p.Q = (u16*)take((size_t)TOK * 512 * 2);
  p.K = (u16*)take((size_t)TOK * 512 * 2);
  p.Vt = (u16*)take((size_t)TOK * 512 * 2);
  p.GA = (u16*)take((size_t)TOK * 512 * 2);
  p.GB = (u16*)take((size_t)TOK * 512 * 2);
  p.PB = (u16*)take((size_t)TOK * PBW * 2); p.Hs = p.PB;
  p.Ymix = (u16*)take((size_t)TOK * DM * 2);
  p.BV = (u16*)take((size_t)TOK * 512 * 2);
  p.DUt = (u16*)take(512 * 64 * 2); p.IUt = (u16*)take(512 * 64 * 2);
  p.rs = (float*)take((size_t)TOK * 4); p.ssq = (float*)take((size_t)TOK * 4);
  p.ctab = (float*)take((size_t)SEQ * 32 * 4); p.stab = (float*)take((size_t)SEQ * 32 * 4);
  p.kmean = (float*)take((size_t)64 * 16 * 64 * 4);
  p.qctr = (int*)take(256);
  p.pcnt = (int*)take(128 * 4);
  p.xbar = (unsigned*)take(XCD_BAR_WORDS * 4);
  p.QT = (u16*)d_out; p.Y0 = (u16*)d_out + (size_t)4096 * 4096;

  static int grid_blocks = 0;
  if (!grid_blocks) {
    int dev = 0, cus = 0, per_cu = 0;
    hipGetDevice(&dev);
    hipDeviceGetAttribute(&cus, hipDeviceAttributeMultiprocessorCount, dev);
    hipFuncSetAttribute((const void*)fwd_mega, hipFuncAttributeMaxDynamicSharedMemorySize, LDS_BYTES);
    hipOccupancyMaxActiveBlocksPerMultiprocessor(&per_cu, fwd_mega, NT, LDS_BYTES);
    if (per_cu < 1) per_cu = 1;
    if (per_cu > 1) per_cu = 1;
    grid_blocks = cus * per_cu;
#if N_LAUNCH_SPLIT
    hipFuncSetAttribute((const void*)k_prep, hipFuncAttributeMaxDynamicSharedMemorySize, LDS_BYTES);
    hipFuncSetAttribute((const void*)k_gemm1, hipFuncAttributeMaxDynamicSharedMemorySize, LDS_BYTES);
    hipFuncSetAttribute((const void*)k_mix, hipFuncAttributeMaxDynamicSharedMemorySize, LDS_BYTES);
    hipFuncSetAttribute((const void*)k_gemm2, hipFuncAttributeMaxDynamicSharedMemorySize, LDS_BYTES);
    hipFuncSetAttribute((const void*)k_scan, hipFuncAttributeMaxDynamicSharedMemorySize, LDS_BYTES);
#endif
  }
#if N_LAUNCH_SPLIT
  const int G = grid_blocks;
  k_prep<<<G, NT, LDS_BYTES, stream>>>(p);
#if DBG_STAGE < 3
  hipMemsetAsync(p.Ymix, 0, (size_t)TOK * DM * 2, stream);
#endif
#if DBG_STAGE >= 1
  k_gemm1<<<G, NT, LDS_BYTES, stream>>>(p);
#endif
#if DBG_STAGE >= 2
  k_mix<<<G, NT, LDS_BYTES, stream>>>(p);
#endif
#if DBG_STAGE >= 3
  k_scan<<<G, NT, LDS_BYTES, stream>>>(p);
  k_rout<<<G, NT, 0, stream>>>(p);
#endif
  k_gemm2<<<G, NT, LDS_BYTES, stream>>>(p);
  k_final<<<G, NT, 0, stream>>>(p);
#else
  (void)hipMemsetAsync(p.xbar, 0, XCD_BAR_WORDS * 4, stream);
  void* args[] = {&p};
  hipError_t e = hipLaunchCooperativeKernel((const void*)fwd_mega, dim3(grid_blocks), dim3(NT), args, LDS_BYTES, stream);
  if (e != hipSuccess) fprintf(stderr, "cooperative launch failed: %s (grid %d)\n", hipGetErrorString(e), grid_blocks);
#endif
}
```
